# Optimizing an MI355X kernel written in HIP

```python
import jax, jax.numpy as jnp
from jax import lax
import numpy as np

D_MODEL = 1024
BATCH = 32
SEQ = 2048
DEPTH = 4

N_A_LAYERS = DEPTH // 2
N_B_LAYERS = DEPTH - N_A_LAYERS
LRU_WIDTH = D_MODEL
LRU_HEADS = 8
LRU_BLOCK = LRU_WIDTH // LRU_HEADS
CONV_WIDTH = 4
LRU_C = 8.0
HEAD_DIM = 64
N_HEADS = D_MODEL // HEAD_DIM
N_KV_GROUPS = 4
HEADS_PER_GROUP = N_HEADS // N_KV_GROUPS
CMP_BLOCK = 32
CMP_STRIDE = 16
CMP_HIDDEN = 256
SLC_BLOCK = 64
SLC_TOPK = 16
N_LOCAL_BLOCKS = 2
WINDOW = 512
Q_BLOCK = 128
ROPE_THETA = 10000.0
FFN_HIDDEN = ((8 * D_MODEL // 3 + 255) // 256) * 256
EPS = 1e-6
NEG = -1e30
FORCE = 1e30

kernel_name = "yoco_rglru_nsa_hybrid"


def rmsnorm(x, g):
    xf = x.astype(jnp.float32)
    y = xf * lax.rsqrt(jnp.mean(xf * xf, axis=-1, keepdims=True) + EPS)
    return (y * g.astype(jnp.float32)).astype(x.dtype)


def rope(x, pos):
    half = HEAD_DIM // 2
    freqs = jnp.power(ROPE_THETA, -jnp.arange(half, dtype=jnp.float32) / half)
    ang = pos.astype(jnp.float32)[:, None] * freqs[None, :]
    cos = jnp.cos(ang)[:, None, :]
    sin = jnp.sin(ang)[:, None, :]
    xf = x.astype(jnp.float32)
    x1, x2 = xf[..., :half], xf[..., half:]
    return jnp.concatenate([x1 * cos - x2 * sin, x1 * sin + x2 * cos], axis=-1).astype(x.dtype)


def masked_softmax(s, mask):
    s = jnp.where(mask, s, NEG)
    return jax.nn.softmax(s, axis=-1) * mask


def causal_conv(x, w, b):
    S = x.shape[1]
    xp = jnp.pad(x, ((0, 0), (CONV_WIDTH - 1, 0), (0, 0)))
    out = b
    for k in range(CONV_WIDTH):
        out = out + xp[:, k:k + S] * w[k]
    return out


def rg_lru(x, gate_w, gate_b, lam):
    B, S, R = x.shape
    xf = x.astype(jnp.float32)
    xh = xf.reshape(B, S, LRU_HEADS, LRU_BLOCK)
    gates = jnp.einsum('bshi,khij->kbshj', xh, gate_w.astype(jnp.float32)).reshape(2, B, S, R)
    gates = gates + gate_b.astype(jnp.float32)[:, None, None, :]
    r = jax.nn.sigmoid(gates[0])
    i = jax.nn.sigmoid(gates[1])
    log_a = -LRU_C * jax.nn.softplus(-lam.astype(jnp.float32)) * r
    a = jnp.exp(log_a)
    bterm = jnp.sqrt(-jnp.expm1(2.0 * log_a)) * (i * xf)

    def combine(e1, e2):
        a1, b1 = e1
        a2, b2 = e2
        return a1 * a2, a2 * b1 + b2

    _, h = lax.associative_scan(combine, (a, bterm), axis=1)
    return h.astype(x.dtype)


def recurrent_block(h, norm_g, w_in, conv_w, conv_b, gate_w, gate_b, lam, w_out):
    u = rmsnorm(h, norm_g)
    z = u @ w_in
    y = jax.nn.gelu(z[..., :LRU_WIDTH])
    xr = causal_conv(z[..., LRU_WIDTH:], conv_w, conv_b)
    hr = rg_lru(xr, gate_w, gate_b, lam)
    return (y * hr) @ w_out


def swiglu(h, norm_g, w_in, w_out):
    u = rmsnorm(h, norm_g)
    gu = u @ w_in
    return (jax.nn.silu(gu[..., :FFN_HIDDEN]) * gu[..., FFN_HIDDEN:]) @ w_out


def compress(t, pos_emb, w1, b1, w2, b2):
    B, S = t.shape[0], t.shape[1]
    n_cmp = (S - CMP_BLOCK) // CMP_STRIDE + 1
    idx = jnp.arange(n_cmp)[:, None] * CMP_STRIDE + jnp.arange(CMP_BLOCK)[None, :]
    blocks = t[:, idx] + pos_emb[:, None, :]
    blocks = blocks.transpose(0, 1, 3, 2, 4).reshape(B, n_cmp, N_KV_GROUPS, CMP_BLOCK * HEAD_DIM)
    return jax.nn.gelu(blocks @ w1 + b1) @ w2 + b2


def shared_kv(h, kv_norm, kv_w, k_norm, cmp_pos, cmp_w1, cmp_b1, cmp_w2, cmp_b2):
    B, S, _ = h.shape
    u = rmsnorm(h, kv_norm)
    kv = (u @ kv_w).reshape(B, S, 6, N_KV_GROUPS, HEAD_DIM)
    k_c, v_c, k_s, v_s, k_w, v_w = [kv[:, :, j] for j in range(6)]
    pos = jnp.arange(S)
    k_s = rope(rmsnorm(k_s, k_norm[1]), pos)
    k_w = rope(rmsnorm(k_w, k_norm[2]), pos)
    n_cmp = (S - CMP_BLOCK) // CMP_STRIDE + 1
    cmp_last = jnp.arange(n_cmp) * CMP_STRIDE + CMP_BLOCK - 1
    k_cmp = compress(k_c, cmp_pos[0], cmp_w1[0], cmp_b1[0], cmp_w2[0], cmp_b2[0])
    k_cmp = rope(rmsnorm(k_cmp, k_norm[0]), cmp_last)
    v_cmp = compress(v_c, cmp_pos[1], cmp_w1[1], cmp_b1[1], cmp_w2[1], cmp_b2[1])
    return (k_cmp, v_cmp, k_s, v_s, k_w, v_w)


def nsa_single(args):
    q, gate, k_cmp, v_cmp, k_slc, v_slc, k_win, v_win = args
    S = q.shape[0]
    G, Hg, dk = N_KV_GROUPS, HEADS_PER_GROUP, HEAD_DIM
    n_cmp = k_cmp.shape[0]
    n_slc = S // SLC_BLOCK
    top_n = min(SLC_TOPK, n_slc)
    scale = HEAD_DIM ** -0.5
    cmp_start = jnp.arange(n_cmp) * CMP_STRIDE
    cmp_last = cmp_start + CMP_BLOCK - 1
    slc_start = jnp.arange(n_slc) * SLC_BLOCK
    overlap = jnp.clip(jnp.minimum(cmp_start[:, None] + CMP_BLOCK, slc_start[None, :] + SLC_BLOCK)
                       - jnp.maximum(cmp_start[:, None], slc_start[None, :]), 0).astype(jnp.float32) / CMP_BLOCK
    kb = k_slc.reshape(n_slc, SLC_BLOCK, G, dk).transpose(2, 0, 1, 3)
    vb = v_slc.reshape(n_slc, SLC_BLOCK, G, dk).transpose(2, 0, 1, 3)
    kw_p = jnp.pad(k_win, ((WINDOW, 0), (0, 0), (0, 0)))
    vw_p = jnp.pad(v_win, ((WINDOW, 0), (0, 0), (0, 0)))
    qg = q.reshape(S, G, Hg, dk)
    blk = jnp.arange(n_slc)
    grp = jnp.arange(G)[None, :, None]

    def block(qb):
        s0 = qb * Q_BLOCK
        qt = lax.dynamic_slice_in_dim(qg, s0, Q_BLOCK, 0)
        gt = lax.dynamic_slice_in_dim(gate, s0, Q_BLOCK, 0).reshape(Q_BLOCK, 3, G, Hg)
        t = s0 + jnp.arange(Q_BLOCK)
        s = jnp.einsum('tghd,cgd->tghc', qt, k_cmp).astype(jnp.float32) * scale
        p_cmp = masked_softmax(s, (cmp_last[None, :] <= t[:, None])[:, None, None, :])
        o_cmp = jnp.einsum('tghc,cgd->tghd', p_cmp.astype(v_cmp.dtype), v_cmp)
        imp = jnp.einsum('tgc,cj->tgj', p_cmp.sum(axis=2), overlap)
        cur = (t // SLC_BLOCK)[:, None]
        causal_blk = blk[None, :] <= cur
        forced = (blk[None, :] == 0) | (causal_blk & (cur - blk[None, :] < N_LOCAL_BLOCKS))
        score = jnp.where(forced[:, None, :], FORCE, jnp.where(causal_blk[:, None, :], imp, NEG))
        _, idx = lax.top_k(score, top_n)
        ksel = kb[grp, idx].reshape(Q_BLOCK, G, top_n * SLC_BLOCK, dk)
        vsel = vb[grp, idx].reshape(Q_BLOCK, G, top_n * SLC_BLOCK, dk)
        kpos = (idx[..., None] * SLC_BLOCK + jnp.arange(SLC_BLOCK)).reshape(Q_BLOCK, G, top_n * SLC_BLOCK)
        s = jnp.einsum('tghd,tgkd->tghk', qt, ksel).astype(jnp.float32) * scale
        p = masked_softmax(s, (kpos <= t[:, None, None])[:, :, None, :])
        o_slc = jnp.einsum('tghk,tgkd->tghd', p.astype(vsel.dtype), vsel)
        kw = lax.dynamic_slice_in_dim(kw_p, s0, WINDOW + Q_BLOCK, 0)
        vw = lax.dynamic_slice_in_dim(vw_p, s0, WINDOW + Q_BLOCK, 0)
        kp = s0 - WINDOW + jnp.arange(WINDOW + Q_BLOCK)
        mw = (kp[None, :] <= t[:, None]) & (kp[None, :] > t[:, None] - WINDOW) & (kp[None, :] >= 0)
        s = jnp.einsum('tghd,kgd->tghk', qt, kw).astype(jnp.float32) * scale
        p = masked_softmax(s, mw[:, None, None, :])
        o_win = jnp.einsum('tghk,kgd->tghd', p.astype(vw.dtype), vw)
        o = gt[:, 0][..., None] * o_cmp + gt[:, 1][..., None] * o_slc + gt[:, 2][..., None] * o_win
        return o.reshape(Q_BLOCK, N_HEADS, dk)

    out = lax.map(block, jnp.arange(S // Q_BLOCK))
    return out.reshape(S, N_HEADS, dk)


def nsa_layer(h, norm_g, w_in, gate_b, q_norm_g, w_out, k_cmp, v_cmp, k_s, v_s, k_w, v_w):
    B, S, _ = h.shape
    u = rmsnorm(h, norm_g)
    z = u @ w_in
    q = z[..., :N_HEADS * HEAD_DIM].reshape(B, S, N_HEADS, HEAD_DIM)
    q = rope(rmsnorm(q, q_norm_g), jnp.arange(S))
    gates = jax.nn.sigmoid(z[..., N_HEADS * HEAD_DIM:] + gate_b).reshape(B, S, 3, N_HEADS)
    o = lax.map(nsa_single, (q, gates, k_cmp, v_cmp, k_s, v_s, k_w, v_w))
    return o.reshape(B, S, N_HEADS * HEAD_DIM) @ w_out


def setup_inputs(seed: int = 0) -> dict:
    key = jax.random.key(seed)
    ks = jax.random.split(key, 26)

    def nrm(k, shape, scale):
        return jax.random.normal(k, shape, jnp.float32) * scale

    def gain(k, shape):
        return 1.0 + 0.02 * jax.random.normal(k, shape, jnp.float32)

    R, NA, NB = LRU_WIDTH, N_A_LAYERS, N_B_LAYERS
    u = jax.random.uniform(ks[7], (NA, R), jnp.float32, minval=0.9, maxval=0.999)
    s = u ** (1.0 / LRU_C)
    a_lambda = jnp.log(s) - jnp.log1p(-s)
    nq = N_HEADS * HEAD_DIM + 3 * N_HEADS
    return {
        "x": nrm(ks[0], (BATCH, SEQ, D_MODEL), 1.0),
        "a_norm": gain(ks[1], (NA, D_MODEL)),
        "a_w_in": nrm(ks[2], (NA, D_MODEL, 2 * R), D_MODEL ** -0.5),
        "a_conv_w": nrm(ks[3], (NA, CONV_WIDTH, R), CONV_WIDTH ** -0.5),
        "a_conv_b": nrm(ks[4], (NA, R), 0.01),
        "a_gate_w": nrm(ks[5], (NA, 2, LRU_HEADS, LRU_BLOCK, LRU_BLOCK), LRU_BLOCK ** -0.5),
        "a_gate_b": nrm(ks[6], (NA, 2, R), 0.01),
        "a_lambda": a_lambda,
        "a_w_out": nrm(ks[8], (NA, R, D_MODEL), R ** -0.5),
        "kv_norm": gain(ks[9], (D_MODEL,)),
        "kv_w": nrm(ks[10], (D_MODEL, 6 * N_KV_GROUPS * HEAD_DIM), D_MODEL ** -0.5),
        "k_norm": gain(ks[11], (3, HEAD_DIM)),
        "cmp_pos": nrm(ks[12], (2, CMP_BLOCK, HEAD_DIM), 0.02),
        "cmp_w1": nrm(ks[13], (2, CMP_BLOCK * HEAD_DIM, CMP_HIDDEN), (CMP_BLOCK * HEAD_DIM) ** -0.5),
        "cmp_b1": nrm(ks[14], (2, CMP_HIDDEN), 0.01),
        "cmp_w2": nrm(ks[15], (2, CMP_HIDDEN, HEAD_DIM), CMP_HIDDEN ** -0.5),
        "cmp_b2": nrm(ks[16], (2, HEAD_DIM), 0.01),
        "b_norm": gain(ks[17], (NB, D_MODEL)),
        "b_w_in": nrm(ks[18], (NB, D_MODEL, nq), D_MODEL ** -0.5),
        "b_gate_b": nrm(ks[19], (NB, 3 * N_HEADS), 0.01),
        "q_norm": gain(ks[20], (NB, HEAD_DIM)),
        "b_w_out": nrm(ks[21], (NB, N_HEADS * HEAD_DIM, D_MODEL), (N_HEADS * HEAD_DIM) ** -0.5),
        "f_norm": gain(ks[22], (DEPTH, D_MODEL)),
        "f_w_in": nrm(ks[23], (DEPTH, D_MODEL, 2 * FFN_HIDDEN), D_MODEL ** -0.5),
        "f_w_out": nrm(ks[24], (DEPTH, FFN_HIDDEN, D_MODEL), FFN_HIDDEN ** -0.5),
    }


def reference(x, a_norm, a_w_in, a_conv_w, a_conv_b, a_gate_w, a_gate_b, a_lambda, a_w_out,
              kv_norm, kv_w, k_norm, cmp_pos, cmp_w1, cmp_b1, cmp_w2, cmp_b2,
              b_norm, b_w_in, b_gate_b, q_norm, b_w_out,
              f_norm, f_w_in, f_w_out):
    h = x
    shared = None
    for layer in range(DEPTH):
        if layer < N_A_LAYERS:
            i = layer
            h = h + recurrent_block(h, a_norm[i], a_w_in[i], a_conv_w[i], a_conv_b[i],
                                    a_gate_w[i], a_gate_b[i], a_lambda[i], a_w_out[i])
        else:
            if layer == N_A_LAYERS:
                shared = shared_kv(h, kv_norm, kv_w, k_norm, cmp_pos, cmp_w1, cmp_b1, cmp_w2, cmp_b2)
            j = layer - N_A_LAYERS
            h = h + nsa_layer(h, b_norm[j], b_w_in[j], b_gate_b[j], q_norm[j], b_w_out[j], *shared)
        h = h + swiglu(h, f_norm[layer], f_w_in[layer], f_w_out[layer])
    return h
```

```cpp
#include <hip/hip_runtime.h>
#include <hip/hip_cooperative_groups.h>
#include <cstdio>
#include <cstdint>
namespace cg = cooperative_groups;

typedef unsigned short u16;
typedef short bf16x8 __attribute__((ext_vector_type(8)));
typedef float f32x4 __attribute__((ext_vector_type(4)));
typedef unsigned u32x4 __attribute__((ext_vector_type(4)));

#define T_TOK 65536
#define SEQL 2048
#define FHID 2816
#define NTHREADS 256
#define XCD_BAR_BYTES 16384
#define SMEM_BYTES 74240
#ifndef ABL_A
#define ABL_A 1.f
#endif
#ifndef ABL_B
#define ABL_B 1.f
#endif
#ifndef ABL_F
#define ABL_F 1.f
#endif
#define PREP_TILES (1024 + 512 + 384 + 256 + 16 + 576 + 512 + 5632 + 2816)

constexpr size_t OFF_W_AIN  = 0;
constexpr size_t OFF_W_GATE = OFF_W_AIN  + (size_t)2 * 2048 * 1024 * 2;
constexpr size_t OFF_W_AOUT = OFF_W_GATE + (size_t)64 * 128 * 128 * 2;
constexpr size_t OFF_W_KV   = OFF_W_AOUT + (size_t)2 * 1024 * 1024 * 2;
constexpr size_t OFF_W_C1   = OFF_W_KV   + (size_t)1536 * 1024 * 2;
constexpr size_t OFF_W_C2   = OFF_W_C1   + (size_t)2 * 256 * 2048 * 2;
constexpr size_t OFF_W_BIN  = OFF_W_C2   + (size_t)2 * 128 * 256 * 2;
constexpr size_t OFF_W_BOUT = OFF_W_BIN  + (size_t)2 * 1152 * 1024 * 2;
constexpr size_t OFF_W_FIN  = OFF_W_BOUT + (size_t)2 * 1024 * 1024 * 2;
constexpr size_t OFF_W_FOUT = OFF_W_FIN  + (size_t)4 * 5632 * 1024 * 2;
constexpr size_t OFF_ROPE   = OFF_W_FOUT + (size_t)4 * 1024 * 2816 * 2;
constexpr size_t OFF_PB     = OFF_ROPE   + (size_t)2048 * 32 * 2 * 4;
constexpr size_t OFF_U      = OFF_PB     + (size_t)2 * 16 * 256 * 4;
constexpr size_t OFF_BUFA   = OFF_U      + (size_t)T_TOK * 1024 * 2;
constexpr size_t OFF_KC     = OFF_BUFA   + (size_t)T_TOK * FHID * 2;
constexpr size_t OFF_VC     = OFF_KC     + (size_t)T_TOK * 256 * 2;
constexpr size_t OFF_KS     = OFF_VC     + (size_t)T_TOK * 256 * 2;
constexpr size_t OFF_KW     = OFF_KS     + (size_t)T_TOK * 256 * 2;
constexpr size_t OFF_VST    = OFF_KW     + (size_t)T_TOK * 256 * 2;
constexpr size_t OFF_VWT    = OFF_VST    + (size_t)T_TOK * 256 * 2;
constexpr size_t OFF_KCMP   = OFF_VWT    + (size_t)T_TOK * 256 * 2;
constexpr size_t OFF_VCMPT  = OFF_KCMP   + (size_t)128 * 128 * 64 * 2;
constexpr size_t OFF_HID    = OFF_VCMPT  + (size_t)128 * 64 * 128 * 2;
constexpr size_t OFF_GATES  = OFF_HID    + (size_t)2 * 16256 * 256 * 2;
#define OFF_FLAG (OFF_GATES + (size_t)T_TOK * 48 * 4)
#define OFF_BAR (OFF_FLAG + 16384)
constexpr size_t WS_END     = OFF_GATES  + (size_t)T_TOK * 48 * 4 + 16384 + XCD_BAR_BYTES;

struct KArgs {
  const float* in[25];
  float* out;
  char* ws;
  int lo, hi;
};
enum { I_X = 0, I_ANORM, I_AWIN, I_ACONVW, I_ACONVB, I_AGATEW, I_AGATEB, I_ALAM, I_AWOUT, I_KVNORM, I_KVW, I_KNORM,
       I_CMPPOS, I_CMPW1, I_CMPB1, I_CMPW2, I_CMPB2, I_BNORM, I_BWIN, I_BGATEB, I_QNORM, I_BWOUT, I_FNORM, I_FWIN, I_FWOUT };

__device__ __forceinline__ unsigned pack2(float lo, float hi) { unsigned r; asm("v_cvt_pk_bf16_f32 %0, %1, %2" : "=v"(r) : "v"(lo), "v"(hi)); return r; }
__device__ __forceinline__ u16 f2bf(float f) { return (u16)pack2(f, f); }
__device__ __forceinline__ float bf2f(u16 h) { return __uint_as_float(((unsigned)h) << 16); }
__device__ __forceinline__ float sigmoidf_(float x) { return 1.f / (1.f + __expf(-x)); }
__device__ __forceinline__ float gelu_tanh(float x) { float u = 0.7978845608028654f * (x + 0.044715f * x * x * x); return x / (1.f + __expf(-2.f * u)); }
__device__ __forceinline__ f32x4 mfma16(bf16x8 a, bf16x8 b, f32x4 c) { return __builtin_amdgcn_mfma_f32_16x16x32_bf16(a, b, c, 0, 0, 0); }

__device__ __forceinline__ int otid() { int t = threadIdx.x; asm volatile("" : "+v"(t)); return t; }

#define LDS_AS __attribute__((address_space(3)))
struct APlain {
  const u16* A; int lda;
  __device__ __forceinline__ const u16* rowptr(int row) const { return A + (size_t)row * lda; }
  __device__ __forceinline__ int kstride() const { return 64; }
};
struct ACmp {
  const u16* kc;
  __device__ __forceinline__ const u16* rowptr(int row) const {
    const int g = row & 3, bc = row >> 2, b = bc / 127, c = bc - b * 127;
    return kc + ((size_t)(b * SEQL + c * 16) * 256 + g * 64);
  }
  __device__ __forceinline__ int kstride() const { return 256; }
};

template <class AP, class EP>
__device__ __forceinline__ void gemm_tile(const AP& ap, const u16* __restrict__ Bt, int K, int m0, int n0, const EP& ep, char* smem) {
  const int tid = otid(), lane = tid & 63, w = tid >> 6, wm = w >> 1, wn = w & 1, c16 = lane & 15, quad = lane >> 4;
  const int nk = K >> 6;
  const int srow = lane >> 2;
  const int scol = (w & 1) * 32 + ((((lane & 3) * 16) ^ ((lane >> 5) << 5)) >> 1);
  const u16* ga[4]; const u16* gb[4];
#pragma unroll
  for (int p = 0; p < 4; ++p) {
    const int R = ((w >> 1) + 2 * p) * 16 + srow;
    ga[p] = ap.rowptr(m0 + R) + scol;
    gb[p] = Bt + (size_t)(n0 + R) * K + scol;
  }
  const int kstr = ap.kstride();
  const int lofs = (c16 * 64 + quad * 16) ^ ((c16 >> 3) << 5);
  f32x4 acc[4][4];
#pragma unroll
  for (int i = 0; i < 4; ++i)
#pragma unroll
    for (int j = 0; j < 4; ++j) acc[i][j] = f32x4{0.f, 0.f, 0.f, 0.f};

#define GSTAGE(buf_, kt_)                                                                                                        \
  _Pragma("unroll") for (int p = 0; p < 4; ++p) {                                                                                \
    __builtin_amdgcn_global_load_lds((const unsigned*)(ga[p] + (size_t)(kt_) * kstr),                                            \
                                     (LDS_AS unsigned*)(smem + (buf_) * 32768 + w * 1024 + p * 4096), 16, 0, 0);                 \
    __builtin_amdgcn_global_load_lds((const unsigned*)(gb[p] + (size_t)(kt_) * 64),                                              \
                                     (LDS_AS unsigned*)(smem + (buf_) * 32768 + 16384 + w * 1024 + p * 4096), 16, 0, 0);         \
  }
  GSTAGE(0, 0);
  asm volatile("s_waitcnt vmcnt(0)" ::: "memory");
  __syncthreads();
  for (int kt = 0; kt < nk; ++kt) {
    const int cur = kt & 1;
    if (kt + 1 < nk) { GSTAGE(cur ^ 1, kt + 1); }
    const char* pa = smem + cur * 32768 + (wm * 8) * 1024 + lofs;
    const char* pb = smem + cur * 32768 + 16384 + (wn * 8) * 1024 + lofs;
#pragma unroll
    for (int ks = 0; ks < 2; ++ks) {
      bf16x8 af[4], bfr[4];
#pragma unroll
      for (int i = 0; i < 4; ++i) { af[i] = *(const bf16x8*)(pa + (i * 2 + ks) * 1024); bfr[i] = *(const bf16x8*)(pb + (i * 2 + ks) * 1024); }
      __builtin_amdgcn_s_setprio(1);
#pragma unroll
      for (int i = 0; i < 4; ++i)
#pragma unroll
        for (int j = 0; j < 4; ++j) acc[i][j] = EP::TR ? mfma16(bfr[j], af[i], acc[i][j]) : mfma16(af[i], bfr[j], acc[i][j]);
      __builtin_amdgcn_s_setprio(0);
    }
    __builtin_amdgcn_sched_barrier(0);
    asm volatile("s_waitcnt vmcnt(0)" ::: "memory");
    __syncthreads();
  }
#undef GSTAGE
  ep(acc, m0 + wm * 64, n0 + wn * 64, lane);
}

__device__ __forceinline__ bool super_tile(int it, int mtiles, int ntiles, int SN, int& m, int& n) {
  const int nbx = gridDim.x >> 3, x = blockIdx.x & 7, lb = blockIdx.x >> 3;
  const int SM = nbx / SN, scols = (ntiles + SN - 1) / SN;
  const int s = x + 8 * it, sr = s / scols, sc = s - sr * scols;
  m = sr * SM + (lb % SM); n = sc * SN + (lb / SM);
  return (lb < SM * SN) && (m < mtiles) && (n < ntiles);
}
__device__ __forceinline__ int super_iters(int mtiles, int ntiles, int SN) {
  const int nbx = gridDim.x >> 3, SM = nbx / SN;
  const int nsuper = ((ntiles + SN - 1) / SN) * ((mtiles + SM - 1) / SM);
  return (nsuper + 7) >> 3;
}
template <class AP, class EP>
__device__ __forceinline__ void gemm_phase(const AP& ap, const u16* Bt, int K, int mtiles, int ntiles, const EP& ep, char* smem, int SN) {
  const int iters = super_iters(mtiles, ntiles, SN);
  for (int it = 0; it < iters; ++it) {
    int m, n;
    if (super_tile(it, mtiles, ntiles, SN, m, n)) gemm_tile(ap, Bt, K, m * 128, n * 128, ep, smem);
  }
}


__device__ __forceinline__ void head_norm_rope(float (&v)[4], const float* __restrict__ gain, const float* __restrict__ rope, int pos, int c16, float outscale) {
  float ss = v[0] * v[0] + v[1] * v[1] + v[2] * v[2] + v[3] * v[3];
  ss += __shfl_xor(ss, 1); ss += __shfl_xor(ss, 2); ss += __shfl_xor(ss, 4); ss += __shfl_xor(ss, 8);
  const float rs = rsqrtf(ss * (1.f / 64.f) + 1e-6f) * outscale;
  const float y0 = v[0] * rs * gain[c16], y1 = v[1] * rs * gain[16 + c16], y2 = v[2] * rs * gain[32 + c16], y3 = v[3] * rs * gain[48 + c16];
  const float2 cs0 = *(const float2*)(rope + ((size_t)pos * 32 + c16) * 2);
  const float2 cs1 = *(const float2*)(rope + ((size_t)pos * 32 + 16 + c16) * 2);
  v[0] = y0 * cs0.x - y2 * cs0.y; v[2] = y0 * cs0.y + y2 * cs0.x;
  v[1] = y1 * cs1.x - y3 * cs1.y; v[3] = y1 * cs1.y + y3 * cs1.x;
}

struct EpAin {
  static constexpr bool TR = true;
  u16* y; u16* zr;
  __device__ __forceinline__ void operator()(f32x4 (&acc)[4][4], int mb, int nb, int lane) const {
    const int c16 = lane & 15, quad = lane >> 4;
#pragma unroll
    for (int mi = 0; mi < 4; ++mi)
#pragma unroll
      for (int ni = 0; ni < 4; ++ni) {
        const int row = mb + mi * 16 + c16, col = nb + ni * 16 + quad * 4;
        uint2 pk;
        if (nb < 1024) {
          pk.x = pack2(gelu_tanh(acc[mi][ni][0]), gelu_tanh(acc[mi][ni][1])); pk.y = pack2(gelu_tanh(acc[mi][ni][2]), gelu_tanh(acc[mi][ni][3]));
          *(uint2*)(y + (size_t)row * 1024 + col) = pk;
        } else {
          pk.x = pack2(acc[mi][ni][0], acc[mi][ni][1]); pk.y = pack2(acc[mi][ni][2], acc[mi][ni][3]);
          *(uint2*)(zr + (size_t)row * 1024 + col - 1024) = pk;
        }
      }
  }
};
struct EpRes {
  static constexpr bool TR = true;
  const float* res; float* out; float sc;
  __device__ __forceinline__ void operator()(f32x4 (&acc)[4][4], int mb, int nb, int lane) const {
    const int c16 = lane & 15, quad = lane >> 4;
#pragma unroll
    for (int mi = 0; mi < 4; ++mi)
#pragma unroll
      for (int ni = 0; ni < 4; ++ni) {
        const size_t idx = (size_t)(mb + mi * 16 + c16) * 1024 + nb + ni * 16 + quad * 4;
        const float4 r = *(const float4*)(res + idx);
        float4 o; o.x = r.x + sc * acc[mi][ni][0]; o.y = r.y + sc * acc[mi][ni][1]; o.z = r.z + sc * acc[mi][ni][2]; o.w = r.w + sc * acc[mi][ni][3];
        *(float4*)(out + idx) = o;
      }
  }
};
struct EpFfn1 {
  static constexpr bool TR = true;
  u16* act;
  __device__ __forceinline__ void operator()(f32x4 (&acc)[4][4], int mb, int nb, int lane) const {
    const int c16 = lane & 15, quad = lane >> 4;
    const int hb = (nb >> 6) * 32;
#pragma unroll
    for (int mi = 0; mi < 4; ++mi)
#pragma unroll
      for (int ni = 0; ni < 2; ++ni) {
        float v[4];
#pragma unroll
        for (int jj = 0; jj < 4; ++jj) { const float g = acc[mi][ni][jj], u = acc[mi][ni + 2][jj]; v[jj] = g / (1.f + __expf(-g)) * u; }
        uint2 pk; pk.x = pack2(v[0], v[1]); pk.y = pack2(v[2], v[3]);
        *(uint2*)(act + (size_t)(mb + mi * 16 + c16) * FHID + hb + ni * 16 + quad * 4) = pk;
      }
  }
};
struct EpKV {
  static constexpr bool TR = false;
  char* ws; const float* knorm; const float* rope;
  __device__ __forceinline__ void operator()(f32x4 (&acc)[4][4], int mb, int nb, int lane) const {
    const int c16 = lane & 15, quad = lane >> 4;
    const int j6 = nb >> 8, g = (nb & 255) >> 6;
    const int b = mb / SEQL, sb = mb - b * SEQL;
    if (j6 < 2) {
      u16* dst = (u16*)(ws + (j6 == 0 ? OFF_KC : OFF_VC));
#pragma unroll
      for (int mi = 0; mi < 4; ++mi)
#pragma unroll
        for (int ni = 0; ni < 4; ++ni)
#pragma unroll
          for (int j = 0; j < 4; ++j)
            dst[(size_t)(mb + mi * 16 + quad * 4 + j) * 256 + g * 64 + ni * 16 + c16] = f2bf(acc[mi][ni][j]);
    } else if (j6 == 2 || j6 == 4) {
      u16* dst = (u16*)(ws + (j6 == 2 ? OFF_KS : OFF_KW));
      const float* gain = knorm + (j6 == 2 ? 64 : 128);
#pragma unroll
      for (int mi = 0; mi < 4; ++mi)
#pragma unroll
        for (int j = 0; j < 4; ++j) {
          const int s = sb + mi * 16 + quad * 4 + j;
          float v[4] = {acc[mi][0][j], acc[mi][1][j], acc[mi][2][j], acc[mi][3][j]};
          head_norm_rope(v, gain, rope, s, c16, 1.f);
#pragma unroll
          for (int ni = 0; ni < 4; ++ni) dst[((size_t)(b * 4 + g) * SEQL + s) * 64 + ni * 16 + c16] = f2bf(v[ni]);
        }
    } else {
      u16* dst = (u16*)(ws + (j6 == 3 ? OFF_VST : OFF_VWT));
#pragma unroll
      for (int mi = 0; mi < 4; ++mi)
#pragma unroll
        for (int ni = 0; ni < 4; ++ni) {
          const int d = ni * 16 + c16, s = sb + mi * 16 + quad * 4;
          uint2 pk; pk.x = pack2(acc[mi][ni][0], acc[mi][ni][1]); pk.y = pack2(acc[mi][ni][2], acc[mi][ni][3]);
          *(uint2*)(dst + ((size_t)(b * 4 + g) * 64 + d) * SEQL + s) = pk;
        }
    }
  }
};
struct EpCmp1 {
  static constexpr bool TR = false;
  u16* hid; const float* pbpart; const float* b1;
  __device__ __forceinline__ void operator()(f32x4 (&acc)[4][4], int mb, int nb, int lane) const {
    const int c16 = lane & 15, quad = lane >> 4;
#pragma unroll
    for (int ni = 0; ni < 4; ++ni) {
      const int col = nb + ni * 16 + c16;
      float pb = b1[col];
      for (int s = 0; s < 16; ++s) pb += pbpart[s * 256 + col];
#pragma unroll
      for (int mi = 0; mi < 4; ++mi)
#pragma unroll
        for (int j = 0; j < 4; ++j)
          hid[(size_t)(mb + mi * 16 + quad * 4 + j) * 256 + col] = f2bf(gelu_tanh(acc[mi][ni][j] + pb));
    }
  }
};
struct EpCmp2 {
  static constexpr bool TR = false;
  char* ws; int kv; const float* b2; const float* knorm; const float* rope;
  __device__ __forceinline__ void operator()(f32x4 (&acc)[4][4], int mb, int nb, int lane) const {
    if (nb & 64) return;
    const int c16 = lane & 15, quad = lane >> 4;
    float bb[4];
#pragma unroll
    for (int ni = 0; ni < 4; ++ni) bb[ni] = b2[ni * 16 + c16];
#pragma unroll
    for (int mi = 0; mi < 4; ++mi)
#pragma unroll
      for (int j = 0; j < 4; ++j) {
        const int row = mb + mi * 16 + quad * 4 + j;
        const int g = row & 3, bc = row >> 2, b = bc / 127, c = bc - b * 127;
        float v[4] = {acc[mi][0][j] + bb[0], acc[mi][1][j] + bb[1], acc[mi][2][j] + bb[2], acc[mi][3][j] + bb[3]};
        if (kv == 0) {
          head_norm_rope(v, knorm, rope, c * 16 + 31, c16, 1.f);
          u16* dst = (u16*)(ws + OFF_KCMP) + ((size_t)(b * 4 + g) * 128 + c) * 64;
#pragma unroll
          for (int ni = 0; ni < 4; ++ni) dst[ni * 16 + c16] = f2bf(v[ni]);
        } else {
          u16* dst = (u16*)(ws + OFF_VCMPT) + (size_t)(b * 4 + g) * 64 * 128 + c;
#pragma unroll
          for (int ni = 0; ni < 4; ++ni) dst[(size_t)(ni * 16 + c16) * 128] = f2bf(v[ni]);
        }
      }
  }
};
__device__ __forceinline__ void head_norm_rope_t(float (&v)[4][4], const float* __restrict__ gain, const float* __restrict__ rope, int pos, int quad, float outscale) {
  float ss = 0.f;
#pragma unroll
  for (int ni = 0; ni < 4; ++ni)
#pragma unroll
    for (int jj = 0; jj < 4; ++jj) ss += v[ni][jj] * v[ni][jj];
  ss += __shfl_xor(ss, 16); ss += __shfl_xor(ss, 32);
  const float rs = rsqrtf(ss * (1.f / 64.f) + 1e-6f) * outscale;
#pragma unroll
  for (int ni = 0; ni < 2; ++ni) {
    const int d = ni * 16 + quad * 4;
    const float4 g1 = *(const float4*)(gain + d), g2 = *(const float4*)(gain + d + 32);
    const float4 csa = *(const float4*)(rope + ((size_t)pos * 32 + d) * 2), csb = *(const float4*)(rope + ((size_t)pos * 32 + d) * 2 + 4);
    const float g1a[4] = {g1.x, g1.y, g1.z, g1.w}, g2a[4] = {g2.x, g2.y, g2.z, g2.w};
    const float cc[4] = {csa.x, csa.z, csb.x, csb.z}, sn[4] = {csa.y, csa.w, csb.y, csb.w};
#pragma unroll
    for (int jj = 0; jj < 4; ++jj) {
      const float y1 = v[ni][jj] * rs * g1a[jj], y2 = v[ni + 2][jj] * rs * g2a[jj];
      v[ni][jj] = y1 * cc[jj] - y2 * sn[jj];
      v[ni + 2][jj] = y1 * sn[jj] + y2 * cc[jj];
    }
  }
}
struct EpQ {
  static constexpr bool TR = true;
  u16* q; float* gates; const float* qnorm; const float* gate_b; const float* rope;
  __device__ __forceinline__ void operator()(f32x4 (&acc)[4][4], int mb, int nb, int lane) const {
    const int c16 = lane & 15, quad = lane >> 4;
    if (nb < 1024) {
      const float osc = 0.125f * 1.4426950408889634f;
#pragma unroll
      for (int mi = 0; mi < 4; ++mi) {
        const int row = mb + mi * 16 + c16;
        float v[4][4];
#pragma unroll
        for (int ni = 0; ni < 4; ++ni)
#pragma unroll
          for (int jj = 0; jj < 4; ++jj) v[ni][jj] = acc[mi][ni][jj];
        head_norm_rope_t(v, qnorm, rope, row & (SEQL - 1), quad, osc);
#pragma unroll
        for (int ni = 0; ni < 4; ++ni) {
          uint2 pk; pk.x = pack2(v[ni][0], v[ni][1]); pk.y = pack2(v[ni][2], v[ni][3]);
          *(uint2*)(q + (size_t)row * 1024 + nb + ni * 16 + quad * 4) = pk;
        }
      }
    } else if (nb == 1024) {
#pragma unroll
      for (int ni = 0; ni < 3; ++ni) {
        const int gi = ni * 16 + quad * 4;
        const float4 gb = *(const float4*)(gate_b + gi);
#pragma unroll
        for (int mi = 0; mi < 4; ++mi) {
          float4 o;
          o.x = sigmoidf_(acc[mi][ni][0] + gb.x); o.y = sigmoidf_(acc[mi][ni][1] + gb.y);
          o.z = sigmoidf_(acc[mi][ni][2] + gb.z); o.w = sigmoidf_(acc[mi][ni][3] + gb.w);
          *(float4*)(gates + (size_t)(mb + mi * 16 + c16) * 48 + gi) = o;
        }
      }
    }
  }
};

#define XB_TMO      128
#define XB_XCNT(j)  (256  + 64 * (j))
#define XB_XSUB(j)  (1280 + 64 * (j))
#define XB_XGEN(j)  (2304 + 64 * (j))
#define XB_TOP      3328
#define XB_TOPGEN   3392
#define XCD_BAR_WORDS 3456
#define XB_SPIN_CAP (1u << 22)
__device__ __forceinline__ unsigned xb_ld(unsigned* p)              { return __hip_atomic_load(p, __ATOMIC_RELAXED, __HIP_MEMORY_SCOPE_AGENT); }
__device__ __forceinline__ unsigned xb_add(unsigned* p, unsigned v) { return __hip_atomic_fetch_add(p, v, __ATOMIC_RELAXED, __HIP_MEMORY_SCOPE_AGENT); }
__device__ __forceinline__ unsigned xb_xcc_id() { return (unsigned)__builtin_amdgcn_s_getreg((3 << 11) | 20) & 0xFu; }
#define XB_SPIN(cond, bar) do { unsigned _sp = 0; while (cond) { __builtin_amdgcn_s_sleep(1); \
    if ((++_sp & 255u) == 0u) { if (xb_ld(&(bar)[XB_TMO])) break; if (_sp > XB_SPIN_CAP) { atomicAdd(&(bar)[XB_TMO], 1u); break; } } } } while (0)
struct XcdBarrier { unsigned* bar; unsigned x; volatile LDS_AS unsigned* st; };
__device__ __forceinline__ XcdBarrier xcd_barrier_post(unsigned* bar, volatile LDS_AS unsigned* st) {
  XcdBarrier b; b.bar = bar; b.x = xb_xcc_id(); b.st = st;
  if (threadIdx.x == 0) (void)xb_add(&bar[XB_XCNT(b.x)], 1u);
  return b;
}
__device__ __forceinline__ void xcd_barrier_complete(unsigned* bar, unsigned x, unsigned& nloc, unsigned& nx) {
  const unsigned G = gridDim.x * gridDim.y * gridDim.z;
  unsigned sum, cnt, mine, sp = 0u;
  for (;;) {
    sum = 0u; cnt = 0u; mine = 0u;
#pragma unroll
    for (unsigned j = 0; j < 16; ++j) { const unsigned c = xb_ld(&bar[XB_XCNT(j)]); sum += c; cnt += (c > 0u) ? 1u : 0u; mine = (j == x) ? c : mine; }
    if (sum == G) break;
    __builtin_amdgcn_s_sleep(1);
    if ((++sp & 255u) == 0u) { if (xb_ld(&bar[XB_TMO])) break; if (sp > XB_SPIN_CAP) { atomicAdd(&bar[XB_TMO], 1u); break; } }
  }
  nloc = mine > 0u ? mine : 1u; nx = cnt > 0u ? cnt : 1u;
}
__device__ __forceinline__ void xcd_barrier(const XcdBarrier& b) {
  asm volatile("s_waitcnt vmcnt(0)" ::: "memory");
  __syncthreads();
  if (threadIdx.x == 0) {
    unsigned* bar = b.bar;
    __builtin_amdgcn_s_waitcnt(0);
    unsigned nloc = b.st[0], nx = b.st[1];
    if (nloc == 0u) { xcd_barrier_complete(bar, b.x, nloc, nx); b.st[0] = nloc; b.st[1] = nx; }
    const unsigned old = xb_add(&bar[XB_XSUB(b.x)], 1u);
    const unsigned gen = old / nloc;
    if (old + 1u == (gen + 1u) * nloc) {
      __builtin_amdgcn_fence(__ATOMIC_RELEASE, "agent");
      asm volatile("s_waitcnt vmcnt(0)" ::: "memory");
      const unsigned og = xb_add(&bar[XB_TOP], 1u);
      const unsigned tg = og / nx;
      if (og + 1u == (tg + 1u) * nx) xb_add(&bar[XB_TOPGEN], 1u);
      else XB_SPIN(xb_ld(&bar[XB_TOPGEN]) == tg, bar);
      __builtin_amdgcn_fence(__ATOMIC_ACQUIRE, "agent");
      xb_add(&bar[XB_XGEN(b.x)], 1u);
      asm volatile("s_waitcnt vmcnt(0)" ::: "memory");
    } else {
      XB_SPIN(xb_ld(&bar[XB_XGEN(b.x)]) == gen, bar);
      __builtin_amdgcn_fence(__ATOMIC_ACQUIRE, "agent");
      asm volatile("s_waitcnt vmcnt(0)" ::: "memory");
    }
  }
  __syncthreads();
}

__device__ __forceinline__ void norm_phase(const float* __restrict__ h, const float* __restrict__ g, u16* __restrict__ u) {
  const int tidn = otid();
  const int lane = tidn & 63;
  const int gw = blockIdx.x * 4 + (tidn >> 6), nw = gridDim.x * 4;
  float4 gv[4];
#pragma unroll
  for (int i = 0; i < 4; ++i) gv[i] = *(const float4*)(g + i * 256 + lane * 4);
  for (int row = gw; row < T_TOK; row += nw) {
    const float* hr = h + (size_t)row * 1024;
    float4 v[4];
    float ss = 0.f;
#pragma unroll
    for (int i = 0; i < 4; ++i) { v[i] = *(const float4*)(hr + i * 256 + lane * 4); ss += v[i].x * v[i].x + v[i].y * v[i].y + v[i].z * v[i].z + v[i].w * v[i].w; }
#pragma unroll
    for (int o = 32; o >= 1; o >>= 1) ss += __shfl_xor(ss, o);
    const float rs = rsqrtf(ss * (1.f / 1024.f) + 1e-6f);
#pragma unroll
    for (int i = 0; i < 4; ++i) {
      uint2 pk; pk.x = pack2(v[i].x * rs * gv[i].x, v[i].y * rs * gv[i].y); pk.y = pack2(v[i].z * rs * gv[i].z, v[i].w * rs * gv[i].w);
      *(uint2*)(u + (size_t)row * 1024 + i * 256 + lane * 4) = pk;
    }
  }
}

__device__ __forceinline__ void do_transpose(const float* __restrict__ src, u16* __restrict__ dst, int K, int N, int Nd, int mode, int t, char* smem) {
  float* tile = (float*)smem;
  const int tid = otid();
  const int ktn = K >> 6, tpb = ktn * (Nd >> 6);
  const int bi = t / tpb, r = t - bi * tpb, nt = r / ktn, kt = r - nt * ktn;
  const float* sb = src + (size_t)bi * K * N;
  u16* db = dst + (size_t)bi * Nd * K;
  __syncthreads();
#pragma unroll 4
  for (int i = 0; i < 16; ++i) {
    const int e = tid + i * 256, kk = e >> 6, nn = e & 63;
    const int n1 = nt * 64 + nn;
    int sc = n1;
    if (mode == 1) { const int blk = n1 >> 6, rr = n1 & 63; const int hid = blk * 32 + (rr & 31); sc = (rr < 32) ? hid : (FHID + hid); }
    tile[kk * 65 + nn] = (sc < N) ? sb[(size_t)(kt * 64 + kk) * N + sc] : 0.f;
  }
  __syncthreads();
#pragma unroll 4
  for (int i = 0; i < 16; ++i) {
    const int e = tid + i * 256, nn = e >> 6, kk = e & 63;
    db[(size_t)(nt * 64 + nn) * K + kt * 64 + kk] = f2bf(tile[kk * 65 + nn]);
  }
}

__device__ __forceinline__ void prep_phase(const KArgs& a, char* smem) {
  char* ws = a.ws;
  constexpr int TOTAL = PREP_TILES;
  for (int tile = blockIdx.x; tile < TOTAL; tile += gridDim.x) {
    int t = tile;
#define JOB(S, D, K_, N_, ND_, B_, M_)                                                               \
    { constexpr int cnt = (B_) * ((K_) / 64) * ((ND_) / 64);                                         \
      if (t >= 0 && t < cnt) do_transpose((S), (u16*)(ws + (D)), (K_), (N_), (ND_), (M_), t, smem);  \
      t -= cnt; }
    JOB(a.in[I_AWIN],   OFF_W_AIN,  1024, 2048, 2048, 2, 0)
    JOB(a.in[I_AWOUT],  OFF_W_AOUT, 1024, 1024, 1024, 2, 0)
    JOB(a.in[I_KVW],    OFF_W_KV,   1024, 1536, 1536, 1, 0)
    JOB(a.in[I_CMPW1],  OFF_W_C1,   2048, 256,  256,  2, 0)
    JOB(a.in[I_CMPW2],  OFF_W_C2,   256,  64,   128,  2, 0)
    JOB(a.in[I_BWIN],   OFF_W_BIN,  1024, 1072, 1152, 2, 0)
    JOB(a.in[I_BWOUT],  OFF_W_BOUT, 1024, 1024, 1024, 2, 0)
    JOB(a.in[I_FWIN],   OFF_W_FIN,  1024, 5632, 5632, 4, 1)
    JOB(a.in[I_FWOUT],  OFF_W_FOUT, 2816, 1024, 1024, 4, 0)
#undef JOB
  }
  const int tidp = otid();
  const int gt = blockIdx.x * NTHREADS + tidp, ng = gridDim.x * NTHREADS;
  for (int i = gt; i < 2048; i += ng) ((unsigned*)(ws + OFF_FLAG))[i] = 0u;
  {
    const float* gsrc = (const float*)(ws + OFF_HID);
    u16* gdst = (u16*)(ws + OFF_W_GATE);
    for (int i = gt; i < 2 * 2048 * 128; i += ng) {
      const int Lg = i >> 18, n = (i >> 7) & 2047, k = i & 127;
      const int hd = n >> 8, rp = n & 255, half = rp >> 7, q = (rp & 127) >> 6, rr = rp & 63, gate = rr >> 5;
      const int chl = half * 64 + q * 32 + (rr & 31);
      gdst[i] = f2bf(gsrc[((size_t)((Lg * 2 + gate) * 8 + hd) * 128 + k) * 128 + chl]);
    }
  }
  float* rope = (float*)(ws + OFF_ROPE);
  for (int i = gt; i < 2048 * 32; i += ng) {
    const int pos = i >> 5, fi = i & 31;
    const double freq = exp2(-(double)fi * (13.287712379549449 / 32.0));
    const double ang = (double)pos * freq;
    const double n = rint(ang * 0.15915494309189535);
    const float r = (float)(ang - n * 6.283185307179586);
    rope[2 * i] = cosf(r); rope[2 * i + 1] = sinf(r);
  }
  float* pb = (float*)(ws + OFF_PB);
  for (int it = blockIdx.x; it < 32; it += gridDim.x) {
    const int kv = it >> 4, ks = it & 15, n = tidp;
    const float* pos = a.in[I_CMPPOS] + kv * 2048 + ks * 128;
    const float* w1 = a.in[I_CMPW1] + ((size_t)kv * 2048 + ks * 128) * 256 + n;
    float s = 0.f;
    for (int k = 0; k < 128; ++k) s += pos[k] * w1[(size_t)k * 256];
    pb[(kv * 16 + ks) * 256 + n] = s;
  }
  u16* kcmp = (u16*)(ws + OFF_KCMP); u16* vcmpt = (u16*)(ws + OFF_VCMPT);
  for (int i = gt; i < 128 * 64; i += ng) {
    const int bg = i >> 6, d = i & 63;
    kcmp[((size_t)bg * 128 + 127) * 64 + d] = 0;
    vcmpt[((size_t)bg * 64 + d) * 128 + 127] = 0;
  }
}

__device__ __forceinline__ void conv_phase(const KArgs& a, int L) {
  const u16* ZR = (const u16*)(a.ws + OFF_BUFA) + (size_t)T_TOK * 1024;
  u16* XR = (u16*)(a.ws + OFF_U);
  const int gt = blockIdx.x * NTHREADS + otid(), ng = gridDim.x * NTHREADS;
  const int ch0 = (gt & 127) * 8;
  float cw[4][8], cb[8];
#pragma unroll
  for (int c = 0; c < 8; ++c) {
    cb[c] = a.in[I_ACONVB][(size_t)L * 1024 + ch0 + c];
#pragma unroll
    for (int k = 0; k < 4; ++k) cw[k][c] = a.in[I_ACONVW][(size_t)(L * 4 + k) * 1024 + ch0 + c];
  }
  for (int unit = gt; unit < (T_TOK / 16) * 128; unit += ng) {
    const int t0 = (unit >> 7) * 16, s0 = t0 & (SEQL - 1);
    const u16* src = ZR + (size_t)t0 * 1024 + ch0;
    uint4 rows[19];
#pragma unroll
    for (int r = 0; r < 19; ++r) {
      if (s0 + r - 3 >= 0) rows[r] = *(const uint4*)(src + (ptrdiff_t)(r - 3) * 1024);
      else rows[r] = make_uint4(0u, 0u, 0u, 0u);
    }
#pragma unroll
    for (int i = 0; i < 16; ++i) {
      float o[8];
#pragma unroll
      for (int c = 0; c < 8; ++c) o[c] = cb[c];
#pragma unroll
      for (int k = 0; k < 4; ++k) {
        const uint4 v = rows[i + k];
        const unsigned wv[4] = {v.x, v.y, v.z, v.w};
#pragma unroll
        for (int c = 0; c < 4; ++c) {
          o[2 * c] += cw[k][2 * c] * __uint_as_float(wv[c] << 16);
          o[2 * c + 1] += cw[k][2 * c + 1] * __uint_as_float(wv[c] & 0xffff0000u);
        }
      }
      uint4 pk; pk.x = pack2(o[0], o[1]); pk.y = pack2(o[2], o[3]); pk.z = pack2(o[4], o[5]); pk.w = pack2(o[6], o[7]);
      *(uint4*)(XR + (size_t)(t0 + i) * 1024 + ch0) = pk;
    }
  }
}

struct EpGate {
  static constexpr bool TR = false;
  const u16* xr; u16* la; u16* bv; const float* gb; const float* lam;
  __device__ __forceinline__ void operator()(f32x4 (&acc)[4][4], int mb, int nb, int lane) const {
    const int c16 = lane & 15, quad = lane >> 4;
    const int chb = (nb >> 8) * 128 + ((nb >> 7) & 1) * 64 + ((nb >> 6) & 1) * 32;
#pragma unroll
    for (int ni = 0; ni < 2; ++ni) {
      const int ch = chb + ni * 16 + c16;
      const float g0b = gb[ch], g1b = gb[1024 + ch];
      const float cl = -8.f * log1pf(expf(-lam[ch]));
#pragma unroll
      for (int mi = 0; mi < 4; ++mi)
#pragma unroll
        for (int j = 0; j < 4; ++j) {
          const size_t idx = (size_t)(mb + mi * 16 + quad * 4 + j) * 1024 + ch;
          const float r = 1.f / (1.f + __expf(-(acc[mi][ni][j] + g0b)));
          const float ig = 1.f / (1.f + __expf(-(acc[mi][ni + 2][j] + g1b)));
          const float l = cl * r;
          const float av = __expf(l);
          const float bt = sqrtf(fmaxf(1.f - av * av, 0.f)) * (ig * bf2f(xr[idx]));
          la[idx] = f2bf(l); bv[idx] = f2bf(bt);
        }
    }
  }
};

__device__ __forceinline__ void gates_phase(const KArgs& a, int L, char* smem) {
  char* ws = a.ws;
  const u16* XR = (const u16*)(ws + OFF_U);
  EpGate ep{XR, (u16*)(ws + OFF_BUFA) + (size_t)T_TOK * 1024, (u16*)(ws + OFF_KC), a.in[I_AGATEB] + (size_t)L * 2048, a.in[I_ALAM] + (size_t)L * 1024};
  const u16* Bt = (const u16*)(ws + OFF_W_GATE) + (size_t)L * 2048 * 128;
  const int iters = super_iters(512, 16, 4);
  for (int it = 0; it < iters; ++it) {
    int m, n;
    if (super_tile(it, 512, 16, 4, m, n)) {
      APlain ap{XR + (n >> 1) * 128, 1024};
      gemm_tile(ap, Bt, 128, m * 128, n * 128, ep, smem);
    }
  }
}

__device__ __forceinline__ void scan_phase(const KArgs& a, char* smem) {
  float* sP = (float*)smem; float* sH = sP + 256;
  const int tid = otid(), lane = tid & 63, w = tid >> 6;
  const u16* Y = (const u16*)(a.ws + OFF_BUFA);
  const u16* LA = Y + (size_t)T_TOK * 1024;
  const u16* BV = (const u16*)(a.ws + OFF_KC);
  u16* YH = (u16*)(a.ws + OFF_U);
  for (int item = blockIdx.x; item < 512; item += gridDim.x) {
    const int b = item >> 4, ch = (item & 15) * 64 + lane;
    const size_t base = ((size_t)b * SEQL + w * 512) * 1024 + ch;
    float P = 1.f, H = 0.f;
    for (int t = 0; t < 512; t += 16) {
      u16 l8[16], b8[16];
#pragma unroll
      for (int i = 0; i < 16; ++i) { l8[i] = LA[base + (size_t)(t + i) * 1024]; b8[i] = BV[base + (size_t)(t + i) * 1024]; }
#pragma unroll
      for (int i = 0; i < 16; ++i) { const float av = __expf(bf2f(l8[i])); H = av * H + bf2f(b8[i]); P *= av; }
    }
    __syncthreads();
    sP[w * 64 + lane] = P; sH[w * 64 + lane] = H;
    __syncthreads();
    float h = 0.f;
    for (int s2 = 0; s2 < w; ++s2) h = sP[s2 * 64 + lane] * h + sH[s2 * 64 + lane];
    for (int t = 0; t < 512; t += 16) {
      u16 l8[16], b8[16], y8[16];
#pragma unroll
      for (int i = 0; i < 16; ++i) { const size_t idx = base + (size_t)(t + i) * 1024; l8[i] = LA[idx]; b8[i] = BV[idx]; y8[i] = Y[idx]; }
#pragma unroll
      for (int i = 0; i < 16; ++i) {
        h = __expf(bf2f(l8[i])) * h + bf2f(b8[i]);
        YH[base + (size_t)(t + i) * 1024] = f2bf(bf2f(y8[i]) * h);
      }
    }
  }
}

#define SM_SHIFT 8.0f
__device__ __forceinline__ void qk_tile(const u16* Ks, const bf16x8 (&qf)[2][2], f32x4 (&S)[4][2], int c16, int quad) {
#pragma unroll
  for (int mb = 0; mb < 4; ++mb) {
#pragma unroll
    for (int nb = 0; nb < 2; ++nb) S[mb][nb] = f32x4{-SM_SHIFT, -SM_SHIFT, -SM_SHIFT, -SM_SHIFT};
#pragma unroll
    for (int ks = 0; ks < 2; ++ks) {
      const bf16x8 kf = *(const bf16x8*)(Ks + (mb * 16 + c16) * 72 + ks * 32 + quad * 8);
#pragma unroll
      for (int nb = 0; nb < 2; ++nb) S[mb][nb] = mfma16(kf, qf[nb][ks], S[mb][nb]);
    }
  }
}
__device__ __forceinline__ void pv_tile(const u16* Vs, int koff, const f32x4 (&P)[4][2], f32x4 (&O)[4][2], int c16, int quad) {
#pragma unroll
  for (int kk = 0; kk < 2; ++kk) {
    bf16x8 pf[2];
#pragma unroll
    for (int nb = 0; nb < 2; ++nb) {
      u32x4 t;
      t.x = pack2(P[2 * kk][nb][0], P[2 * kk][nb][1]); t.y = pack2(P[2 * kk][nb][2], P[2 * kk][nb][3]);
      t.z = pack2(P[2 * kk + 1][nb][0], P[2 * kk + 1][nb][1]); t.w = pack2(P[2 * kk + 1][nb][2], P[2 * kk + 1][nb][3]);
      pf[nb] = __builtin_bit_cast(bf16x8, t);
    }
#pragma unroll
    for (int db = 0; db < 4; ++db) {
      const u16* vp = Vs + (db * 16 + c16) * 136 + koff + kk * 32 + quad * 4;
      const uint2 lo = *(const uint2*)vp, hi = *(const uint2*)(vp + 16);
      u32x4 t; t.x = lo.x; t.y = lo.y; t.z = hi.x; t.w = hi.y;
      const bf16x8 vf = __builtin_bit_cast(bf16x8, t);
#pragma unroll
      for (int nb = 0; nb < 2; ++nb) O[db][nb] = mfma16(vf, pf[nb], O[db][nb]);
    }
  }
}

template <bool NOMASK, class MaskF>
__device__ __forceinline__ void flash_step(const u16* Ks, const u16* Vs, const bf16x8 (&qf)[2][2], f32x4 (&O)[4][2], float (&m)[2], float (&l)[2],
                                           const MaskF& valid, int c16, int quad) {
  f32x4 S[4][2];
  qk_tile(Ks, qf, S, c16, quad);
#pragma unroll
  for (int nb = 0; nb < 2; ++nb) {
    float rs = 0.f;
#pragma unroll
    for (int mb = 0; mb < 4; ++mb)
#pragma unroll
      for (int j = 0; j < 4; ++j) {
        const float pv = (NOMASK || valid(nb, mb * 16 + j)) ? __builtin_amdgcn_exp2f(S[mb][nb][j]) : 0.f;
        S[mb][nb][j] = pv; rs += pv;
      }
    rs += __shfl_xor(rs, 16); rs += __shfl_xor(rs, 32);
    l[nb] += rs;
  }
  pv_tile(Vs, 0, S, O, c16, quad);
}

__device__ __forceinline__ void attn_phase(const KArgs& a, char* smem) {
  u16* Ks = (u16*)smem;
  u16* Vs = (u16*)(smem + 18432);
  float* impM = (float*)(smem + 35840);
  float* impT = (float*)(smem + 35840 + 16896);
  float* sc = (float*)(smem + 69632);
  unsigned* selm = (unsigned*)(smem + 73856);
  unsigned* anyj = selm + 32;
  const u16* Q = (const u16*)(a.ws + OFF_BUFA);
  u16* Oo = (u16*)(a.ws + OFF_BUFA) + (size_t)T_TOK * 1024;
  const float* gates = (const float*)(a.ws + OFF_GATES);
  const u16* kcmp = (const u16*)(a.ws + OFF_KCMP); const u16* vcmpt = (const u16*)(a.ws + OFF_VCMPT);
  const u16* ksl = (const u16*)(a.ws + OFF_KS); const u16* kwn = (const u16*)(a.ws + OFF_KW);
  const u16* vst = (const u16*)(a.ws + OFF_VST); const u16* vwt = (const u16*)(a.ws + OFF_VWT);

  for (int item = blockIdx.x; item < 8192; item += gridDim.x) {
    const int tid = otid(), lane = tid & 63, w = tid >> 6, c16 = lane & 15, quad = lane >> 4;
    const int qt = 63 - (item >> 7), bg = item & 127, b = bg >> 2, g = bg & 3;
    const int s0 = qt * 32, hq = g * 4 + w;
    const size_t tok0 = (size_t)b * SEQL + s0;
    bf16x8 qf[2][2];
#pragma unroll
    for (int nb = 0; nb < 2; ++nb)
#pragma unroll
      for (int ks = 0; ks < 2; ++ks) qf[nb][ks] = *(const bf16x8*)(Q + (tok0 + nb * 16 + c16) * 1024 + hq * 64 + ks * 32 + quad * 8);
    int tq[2]; tq[0] = s0 + c16; tq[1] = s0 + 16 + c16;
    f32x4 of[4][2];
#pragma unroll
    for (int db = 0; db < 4; ++db)
#pragma unroll
      for (int nb = 0; nb < 2; ++nb) of[db][nb] = f32x4{0.f, 0.f, 0.f, 0.f};

    __syncthreads();
    {
      const u16* kc = kcmp + (size_t)bg * 128 * 64;
      const u16* vc = vcmpt + (size_t)bg * 64 * 128;
#pragma unroll
      for (int i = 0; i < 4; ++i) {
        const int id = tid + i * 256;
        { const int r = id >> 3, c = id & 7; *(uint4*)(Ks + r * 72 + c * 8) = *(const uint4*)(kc + r * 64 + c * 8); }
        { const int r = id >> 4, c = id & 15; *(uint4*)(Vs + r * 136 + c * 8) = *(const uint4*)(vc + r * 128 + c * 8); }
      }
      if (tid < 32) selm[tid] = 0u;
      if (tid == 32) *anyj = 0u;
    }
    __syncthreads();
    {
      int cmax[2]; cmax[0] = ((tq[0] - 31) >> 4) - quad * 4; cmax[1] = ((tq[1] - 31) >> 4) - quad * 4;
      float lC[2] = {0.f, 0.f};
#pragma unroll
      for (int h = 0; h < 2; ++h) {
        if (h == 1 && s0 < 1024) continue;
        f32x4 S[4][2];
        qk_tile(Ks + h * 64 * 72, qf, S, c16, quad);
#pragma unroll
        for (int nb = 0; nb < 2; ++nb) {
          float rs = 0.f;
#pragma unroll
          for (int mb = 0; mb < 4; ++mb)
#pragma unroll
            for (int j = 0; j < 4; ++j) rs += (h * 64 + mb * 16 + j <= cmax[nb]) ? __builtin_amdgcn_exp2f(S[mb][nb][j]) : 0.f;
          rs += __shfl_xor(rs, 16); rs += __shfl_xor(rs, 32);
          lC[nb] += rs;
        }
      }
      float invC[2]; invC[0] = (lC[0] > 0.f) ? 1.f / lC[0] : 0.f; invC[1] = (lC[1] > 0.f) ? 1.f / lC[1] : 0.f;
      f32x4 Oc[4][2];
#pragma unroll
      for (int db = 0; db < 4; ++db)
#pragma unroll
        for (int nb = 0; nb < 2; ++nb) Oc[db][nb] = f32x4{0.f, 0.f, 0.f, 0.f};
#pragma unroll
      for (int h = 0; h < 2; ++h) {
        if (h == 1 && s0 < 1024) continue;
        f32x4 S[4][2];
        qk_tile(Ks + h * 64 * 72, qf, S, c16, quad);
#pragma unroll
        for (int nb = 0; nb < 2; ++nb)
#pragma unroll
          for (int mb = 0; mb < 4; ++mb) {
#pragma unroll
            for (int j = 0; j < 4; ++j)
              S[mb][nb][j] = (h * 64 + mb * 16 + j <= cmax[nb]) ? __builtin_amdgcn_exp2f(S[mb][nb][j]) * invC[nb] : 0.f;
            const int jb = h * 16 + mb * 4 + quad;
            const int idx = (w * 32 + nb * 16 + c16) * 33 + jb;
            impM[idx] = S[mb][nb][0] + S[mb][nb][1] + S[mb][nb][2] + 0.5f * S[mb][nb][3];
            impT[idx] = 0.5f * S[mb][nb][3];
          }
        pv_tile(Vs, h * 64, S, Oc, c16, quad);
      }
#pragma unroll
      for (int nb = 0; nb < 2; ++nb) {
        const float gc = gates[(tok0 + nb * 16 + c16) * 48 + hq];
#pragma unroll
        for (int db = 0; db < 4; ++db) of[db][nb] += Oc[db][nb] * gc;
      }
      __syncthreads();
      {
        const int qq = tid & 31, jg = tid >> 5;
        const int cur = (s0 + qq) >> 6;
#pragma unroll
        for (int k = 0; k < 4; ++k) {
          const int j = jg * 4 + k;
          float imp = 0.f;
#pragma unroll
          for (int ww = 0; ww < 4; ++ww) {
            imp += impM[(ww * 32 + qq) * 33 + j];
            if (j > 0) imp += impT[(ww * 32 + qq) * 33 + j - 1];
          }
          float s = imp;
          if (j > cur) s = -1e30f; else if (j == 0 || cur - j < 2) s = 1e30f;
          sc[qq * 33 + j] = s;
        }
        __syncthreads();
        unsigned bits = 0u;
#pragma unroll
        for (int k = 0; k < 4; ++k) {
          const int j = jg * 4 + k;
          const float sj = sc[qq * 33 + j];
          int cnt = 0;
          for (int i = 0; i < 32; ++i) { const float si = sc[qq * 33 + i]; cnt += (si > sj || (si == sj && i < j)) ? 1 : 0; }
          if (cnt < 16) bits |= 1u << j;
        }
        atomicOr(&selm[qq], bits);
        atomicOr(anyj, bits);
      }
    }
    __syncthreads();
    unsigned sel[2]; sel[0] = selm[c16]; sel[1] = selm[16 + c16];
    const unsigned anym = *anyj;

    {
      f32x4 O2[4][2]; float m[2] = {-1e30f, -1e30f}, l[2] = {0.f, 0.f};
#pragma unroll
      for (int db = 0; db < 4; ++db)
#pragma unroll
        for (int nb = 0; nb < 2; ++nb) O2[db][nb] = f32x4{0.f, 0.f, 0.f, 0.f};
      const int jmax = (s0 + 31) >> 6;
      unsigned rem = anym & ((2u << jmax) - 1u);
      const int r0 = tid >> 3, c0 = tid & 7;
      const u16* kbase = ksl + (size_t)bg * SEQL * 64 + r0 * 64 + c0 * 8;
      const u16* vbase = vst + (size_t)bg * 64 * SEQL + (size_t)r0 * SEQL + c0 * 8;
      uint4 rk0, rk1, rv0, rv1;
      int j = __ffs(rem) - 1;
      rk0 = *(const uint4*)(kbase + (size_t)j * 64 * 64); rk1 = *(const uint4*)(kbase + (size_t)j * 64 * 64 + 32 * 64);
      rv0 = *(const uint4*)(vbase + j * 64); rv1 = *(const uint4*)(vbase + j * 64 + (size_t)32 * SEQL);
      for (;;) {
        rem &= rem - 1u;
        __syncthreads();
        *(uint4*)(Ks + r0 * 72 + c0 * 8) = rk0; *(uint4*)(Ks + (r0 + 32) * 72 + c0 * 8) = rk1;
        *(uint4*)(Vs + r0 * 136 + c0 * 8) = rv0; *(uint4*)(Vs + (r0 + 32) * 136 + c0 * 8) = rv1;
        __syncthreads();
        const int jn = rem ? (__ffs(rem) - 1) : -1;
        if (jn >= 0) {
          rk0 = *(const uint4*)(kbase + (size_t)jn * 64 * 64); rk1 = *(const uint4*)(kbase + (size_t)jn * 64 * 64 + 32 * 64);
          rv0 = *(const uint4*)(vbase + jn * 64); rv1 = *(const uint4*)(vbase + jn * 64 + (size_t)32 * SEQL);
        }
        int lim[2];
        lim[0] = ((sel[0] >> j) & 1u) ? (tq[0] - j * 64 - quad * 4) : -1;
        lim[1] = ((sel[1] >> j) & 1u) ? (tq[1] - j * 64 - quad * 4) : -1;
        auto valid = [&](int nb, int kk) -> bool { return kk <= lim[nb]; };
        const bool full = (j * 64 + 63 <= s0) && __all((int)(((sel[0] >> j) & (sel[1] >> j)) & 1u));
        if (full) flash_step<true>(Ks, Vs, qf, O2, m, l, valid, c16, quad);
        else flash_step<false>(Ks, Vs, qf, O2, m, l, valid, c16, quad);
        if (jn < 0) break;
        j = jn;
      }
#pragma unroll
      for (int nb = 0; nb < 2; ++nb) {
        const float gs = gates[(tok0 + nb * 16 + c16) * 48 + 16 + hq] * ((l[nb] > 0.f) ? 1.f / l[nb] : 0.f);
#pragma unroll
        for (int db = 0; db < 4; ++db) of[db][nb] += O2[db][nb] * gs;
      }
    }
    {
      f32x4 O3[4][2]; float m[2] = {-1e30f, -1e30f}, l[2] = {0.f, 0.f};
#pragma unroll
      for (int db = 0; db < 4; ++db)
#pragma unroll
        for (int nb = 0; nb < 2; ++nb) O3[db][nb] = f32x4{0.f, 0.f, 0.f, 0.f};
      const int jlo = (s0 >= 511) ? ((s0 - 511) >> 6) : 0, jhi = (s0 + 31) >> 6;
      const int r0 = tid >> 3, c0 = tid & 7;
      const u16* kbase = kwn + (size_t)bg * SEQL * 64 + r0 * 64 + c0 * 8;
      const u16* vbase = vwt + (size_t)bg * 64 * SEQL + (size_t)r0 * SEQL + c0 * 8;
      uint4 rk0, rk1, rv0, rv1;
      rk0 = *(const uint4*)(kbase + (size_t)jlo * 64 * 64); rk1 = *(const uint4*)(kbase + (size_t)jlo * 64 * 64 + 32 * 64);
      rv0 = *(const uint4*)(vbase + jlo * 64); rv1 = *(const uint4*)(vbase + jlo * 64 + (size_t)32 * SEQL);
      for (int j = jlo; j <= jhi; ++j) {
        __syncthreads();
        *(uint4*)(Ks + r0 * 72 + c0 * 8) = rk0; *(uint4*)(Ks + (r0 + 32) * 72 + c0 * 8) = rk1;
        *(uint4*)(Vs + r0 * 136 + c0 * 8) = rv0; *(uint4*)(Vs + (r0 + 32) * 136 + c0 * 8) = rv1;
        __syncthreads();
        if (j < jhi) {
          const int jn = j + 1;
          rk0 = *(const uint4*)(kbase + (size_t)jn * 64 * 64); rk1 = *(const uint4*)(kbase + (size_t)jn * 64 * 64 + 32 * 64);
          rv0 = *(const uint4*)(vbase + jn * 64); rv1 = *(const uint4*)(vbase + jn * 64 + (size_t)32 * SEQL);
        }
        int lim[2]; lim[0] = tq[0] - j * 64 - quad * 4; lim[1] = tq[1] - j * 64 - quad * 4;
        auto valid = [&](int nb, int kk) -> bool { return (kk <= lim[nb]) && (kk > lim[nb] - 512); };
        const bool full = (j * 64 + 63 <= s0) && (j * 64 > s0 + 31 - 512);
        if (full) flash_step<true>(Ks, Vs, qf, O3, m, l, valid, c16, quad);
        else flash_step<false>(Ks, Vs, qf, O3, m, l, valid, c16, quad);
      }
#pragma unroll
      for (int nb = 0; nb < 2; ++nb) {
        const float gs = gates[(tok0 + nb * 16 + c16) * 48 + 32 + hq] * ((l[nb] > 0.f) ? 1.f / l[nb] : 0.f);
#pragma unroll
        for (int db = 0; db < 4; ++db) of[db][nb] += O3[db][nb] * gs;
      }
    }
#pragma unroll
    for (int nb = 0; nb < 2; ++nb)
#pragma unroll
      for (int db = 0; db < 4; ++db) {
        uint2 pk; pk.x = pack2(of[db][nb][0], of[db][nb][1]); pk.y = pack2(of[db][nb][2], of[db][nb][3]);
        *(uint2*)(Oo + (tok0 + nb * 16 + c16) * 1024 + hq * 64 + db * 16 + quad * 4) = pk;
      }
  }
}

__device__ __forceinline__ bool dbg_bad(float got, float ref) { return !(fabsf(got - ref) <= 0.03f + 0.04f * fabsf(ref)); }
__device__ __forceinline__ void check_ain(const KArgs& a) {
  const int gt = blockIdx.x * NTHREADS + otid();
  if (gt >= 65536) return;
  const unsigned s = (unsigned)gt;
  const int row = (int)(s & 31u) * 2048, col = (int)(s >> 5);
  const int b = row >> 11, ch = col & 1023;
  const u16* u = (const u16*)(a.ws + OFF_U) + (size_t)row * 1024;
  const float* w = a.in[I_AWIN] + col;
  float acc = 0.f;
  for (int k = 0; k < 1024; ++k) acc += bf2f(u[k]) * w[(size_t)k * 2048];
  const u16* Y = (const u16*)(a.ws + OFF_BUFA);
  float got, ref;
  if (col < 1024) { got = bf2f(Y[(size_t)row * 1024 + col]); ref = gelu_tanh(acc); }
  else { got = bf2f(Y[(size_t)T_TOK * 1024 + (size_t)row * 1024 + col - 1024]); ref = acc; }
  if (dbg_bad(got, ref)) { atomicAdd((unsigned*)(a.ws + OFF_FLAG), 1u); ((unsigned*)(a.ws + OFF_FLAG))[16 + ch] = 1u; ((unsigned*)(a.ws + OFF_FLAG))[1100 + b] = 1u; }

}
__device__ __forceinline__ void check_scan(const KArgs& a) {
  const int gt = blockIdx.x * NTHREADS + otid();
  if (gt >= 32768) return;
  const unsigned s = (unsigned)gt;
  const int b = (int)(s & 31u), ch = (int)(s >> 5), hd = ch >> 7;
  const u16* Y = (const u16*)(a.ws + OFF_BUFA);
  const u16* ZR = Y + (size_t)T_TOK * 1024;
  const float* gw = (const float*)(a.ws + OFF_HID);
  const float lam = a.in[I_ALAM][ch];
  const float cl = -8.f * log1pf(expf(-lam));
  float h = 0.f;
  bool bad = false;
  for (int t = 0; t < 1; ++t) {
    float g0 = a.in[I_AGATEB][ch], g1 = a.in[I_AGATEB][1024 + ch], xme = 0.f;
    for (int i = 0; i < 128; ++i) {
      const int ci = hd * 128 + i;
      float xr = a.in[I_ACONVB][ci];
      for (int k = 0; k < 4; ++k) { const int tt = t - 3 + k; if (tt >= 0) xr += a.in[I_ACONVW][k * 1024 + ci] * bf2f(ZR[((size_t)b * SEQL + tt) * 1024 + ci]); }
      g0 += xr * gw[((size_t)(0 * 8 + hd) * 128 + i) * 128 + (ch & 127)];
      g1 += xr * gw[((size_t)(1 * 8 + hd) * 128 + i) * 128 + (ch & 127)];
      if (ci == ch) xme = xr;
    }
    const float r = 1.f / (1.f + expf(-g0)), ig = 1.f / (1.f + expf(-g1));
    const float la = cl * r, av = expf(la), bt = sqrtf(fmaxf(-expm1f(2.f * la), 0.f)) * ig * xme;
    h = av * h + bt;
    const u16* u = (const u16*)(a.ws + OFF_U) + ((size_t)b * SEQL + t) * 1024;
    float acc = 0.f;
    for (int k = 0; k < 1024; ++k) acc += bf2f(u[k]) * a.in[I_AWIN][(size_t)k * 2048 + ch];
    const float ref = gelu_tanh(acc) * h;
    const float got = bf2f(Y[((size_t)b * SEQL + t) * 1024 + ch]);
    if (t == 0 && dbg_bad(got, ref)) { atomicAdd((unsigned*)(a.ws + OFF_FLAG), 1u); ((unsigned*)(a.ws + OFF_FLAG))[16 + ch] = 1u; ((unsigned*)(a.ws + OFF_FLAG))[1100 + b] = 1u; }
  }
}
__device__ __forceinline__ void check_ffn1(const KArgs& a) {
  const int gt = blockIdx.x * NTHREADS + otid();
  if (gt >= 8192) return;
  const unsigned s = (unsigned)gt;
  const int row = (int)((s * 2654435761u) >> 16), hid = (int)((s * 40503u + 17u) % 2816u);
  const u16* u = (const u16*)(a.ws + OFF_U) + (size_t)row * 1024;
  const float* w = a.in[I_FWIN];
  float g = 0.f, up = 0.f;
  for (int k = 0; k < 1024; ++k) { const float uv = bf2f(u[k]); g += uv * w[(size_t)k * 5632 + hid]; up += uv * w[(size_t)k * 5632 + 2816 + hid]; }
  const float ref = g / (1.f + expf(-g)) * up;
  const float got = bf2f(((const u16*)(a.ws + OFF_BUFA))[(size_t)row * FHID + hid]);

}
__device__ __forceinline__ void check_ffn2(const KArgs& a, const float* hold) {
}

#define N_PHASES 37
#define BISECT_HI N_PHASES

__global__ void __launch_bounds__(NTHREADS, 2) yoco_mega(KArgs a) {
  extern __shared__ __attribute__((aligned(16))) char smem[];
  cg::grid_group grid = cg::this_grid();
  char* ws = a.ws;
  volatile LDS_AS unsigned* xbst = (volatile LDS_AS unsigned*)(smem + SMEM_BYTES - 16);
  if (threadIdx.x == 0) { xbst[0] = 0u; xbst[1] = 0u; }
  __syncthreads();
  const XcdBarrier xb = xcd_barrier_post((unsigned*)(ws + OFF_BAR), xbst);
  const float* rope = (const float*)(ws + OFF_ROPE);
  int ph = 0;
#define GRID_BARRIER() { asm volatile("s_waitcnt vmcnt(0)" ::: "memory"); __builtin_amdgcn_fence(__ATOMIC_RELEASE, "agent"); asm volatile("s_waitcnt vmcnt(0)" ::: "memory"); \
    grid.sync(); __builtin_amdgcn_fence(__ATOMIC_ACQUIRE, "agent"); asm volatile("s_waitcnt vmcnt(0)" ::: "memory"); }
#define PHASE(...) { if (ph >= a.lo && ph < a.hi) { __VA_ARGS__; if (ph + 1 < a.hi) { if (a.lo < 0) { GRID_BARRIER(); } else xcd_barrier(xb); } } ++ph; }
  PHASE(prep_phase(a, smem))
  for (int layer = 0; layer < 4; ++layer) {
    if (layer < 2) {
      const int L = layer;
      const float* hin = (L == 0) ? a.in[I_X] : a.out;
      PHASE(norm_phase(hin, a.in[I_ANORM] + (size_t)L * 1024, (u16*)(ws + OFF_U)))
      PHASE({
        APlain ap{(const u16*)(ws + OFF_U), 1024};
        EpAin ep{(u16*)(ws + OFF_BUFA), (u16*)(ws + OFF_BUFA) + (size_t)T_TOK * 1024};
        gemm_phase(ap, (const u16*)(ws + OFF_W_AIN) + (size_t)L * 2048 * 1024, 1024, 512, 16, ep, smem, 4);
      })
      PHASE(conv_phase(a, L))
      PHASE(gates_phase(a, L, smem))
      PHASE(scan_phase(a, smem))
      PHASE({
        APlain ap{(const u16*)(ws + OFF_U), 1024};
        EpRes ep{hin, a.out, ABL_A};
        gemm_phase(ap, (const u16*)(ws + OFF_W_AOUT) + (size_t)L * 1024 * 1024, 1024, 512, 8, ep, smem, 8);
      })
    } else {
      const int Lb = layer - 2;
      if (Lb == 0) {
        PHASE(norm_phase(a.out, a.in[I_KVNORM], (u16*)(ws + OFF_U)))
        PHASE({
          APlain ap{(const u16*)(ws + OFF_U), 1024};
          EpKV ep{ws, a.in[I_KNORM], rope};
          gemm_phase(ap, (const u16*)(ws + OFF_W_KV), 1024, 512, 12, ep, smem, 4);
        })
        PHASE({
          for (int kv = 0; kv < 2; ++kv) {
            ACmp ap{(const u16*)(ws + (kv == 0 ? OFF_KC : OFF_VC))};
            EpCmp1 ep{(u16*)(ws + OFF_HID) + (size_t)kv * 16256 * 256, (const float*)(ws + OFF_PB) + kv * 16 * 256, a.in[I_CMPB1] + kv * 256};
            gemm_phase(ap, (const u16*)(ws + OFF_W_C1) + (size_t)kv * 256 * 2048, 2048, 127, 2, ep, smem, 2);
          }
        })
        PHASE({
          for (int kv = 0; kv < 2; ++kv) {
            APlain ap{(const u16*)(ws + OFF_HID) + (size_t)kv * 16256 * 256, 256};
            EpCmp2 ep{ws, kv, a.in[I_CMPB2] + kv * 64, a.in[I_KNORM], rope};
            gemm_phase(ap, (const u16*)(ws + OFF_W_C2) + (size_t)kv * 128 * 256, 256, 127, 1, ep, smem, 1);
          }
        })
      }
      PHASE(norm_phase(a.out, a.in[I_BNORM] + (size_t)Lb * 1024, (u16*)(ws + OFF_U)))
      PHASE({
        APlain ap{(const u16*)(ws + OFF_U), 1024};
        EpQ ep{(u16*)(ws + OFF_BUFA), (float*)(ws + OFF_GATES), a.in[I_QNORM] + Lb * 64, a.in[I_BGATEB] + Lb * 48, rope};
        gemm_phase(ap, (const u16*)(ws + OFF_W_BIN) + (size_t)Lb * 1152 * 1024, 1024, 512, 9, ep, smem, 3);
      })
      PHASE(attn_phase(a, smem))
      PHASE({
        APlain ap{(const u16*)(ws + OFF_BUFA) + (size_t)T_TOK * 1024, 1024};
        EpRes ep{a.out, a.out, ABL_B};
        gemm_phase(ap, (const u16*)(ws + OFF_W_BOUT) + (size_t)Lb * 1024 * 1024, 1024, 512, 8, ep, smem, 8);
      })
    }
    PHASE(norm_phase(a.out, a.in[I_FNORM] + (size_t)layer * 1024, (u16*)(ws + OFF_U)))
    PHASE({
      APlain ap{(const u16*)(ws + OFF_U), 1024};
      EpFfn1 ep{(u16*)(ws + OFF_BUFA)};
      gemm_phase(ap, (const u16*)(ws + OFF_W_FIN) + (size_t)layer * 5632 * 1024, 1024, 512, 44, ep, smem, 4);
    })
    PHASE({
      APlain ap{(const u16*)(ws + OFF_BUFA), FHID};
      EpRes ep{a.out, a.out, ABL_F};
      gemm_phase(ap, (const u16*)(ws + OFF_W_FOUT) + (size_t)layer * 1024 * FHID, FHID, 512, 8, ep, smem, 8);
    })
  }
#undef PHASE
}

extern "C" void kernel_launch(void* const* d_in, const int* in_sizes, int n_in, void* d_out, int out_size, void* d_ws, size_t ws_size,
                              hipStream_t stream) {
  static int grid_blocks = 0;
  if (!grid_blocks) {
    int dev = 0, cus = 0, per_cu = 0;
    hipGetDevice(&dev);
    hipDeviceGetAttribute(&cus, hipDeviceAttributeMultiprocessorCount, dev);
    if (hipFuncSetAttribute((const void*)yoco_mega, hipFuncAttributeMaxDynamicSharedMemorySize, SMEM_BYTES) != hipSuccess) fprintf(stderr, "hipFuncSetAttribute failed\n");
    hipOccupancyMaxActiveBlocksPerMultiprocessor(&per_cu, (const void*)yoco_mega, NTHREADS, SMEM_BYTES);
    if (per_cu < 1) per_cu = 1;
    if (per_cu > 2) per_cu = 2;
    grid_blocks = cus * per_cu;
  }
  if (ws_size < WS_END) { fprintf(stderr, "ws too small: %zu < %zu\n", ws_size, (size_t)WS_END); return; }
  { static const int exp_sizes[25] = {65536*1024, 2*1024, 2*1024*2048, 2*4*1024, 2*1024, 2*2*8*128*128, 2*2*1024, 2*1024, 2*1024*1024, 1024, 1024*1536, 3*64, 2*32*64, 2*2048*256, 2*256, 2*256*64, 2*64, 2*1024, 2*1024*1072, 2*48, 2*64, 2*1024*1024, 4*1024, 4*1024*5632, 4*2816*1024};
    if (n_in != 25) return;
    for (int i = 0; i < 25; ++i) if (in_sizes[i] != exp_sizes[i]) { fprintf(stderr, "in_sizes[%d] = %d, expected %d\n", i, in_sizes[i], exp_sizes[i]); return; } }
  KArgs a{};
  for (int i = 0; i < 25; ++i) a.in[i] = (const float*)d_in[i];
  a.out = (float*)d_out;
  a.ws = (char*)d_ws;
  hipMemsetAsync((char*)d_ws + OFF_BAR, 0, XCD_BAR_BYTES, stream);
  hipMemcpyAsync((char*)d_ws + OFF_HID, d_in[5], (size_t)in_sizes[5] * 4, hipMemcpyDeviceToDevice, stream);
#ifdef MULTI_LAUNCH
  for (int ph = 0; ph < N_PHASES; ++ph) {
    a.lo = ph; a.hi = ph + 1;
    hipLaunchKernelGGL(yoco_mega, dim3(grid_blocks), dim3(NTHREADS), SMEM_BYTES, stream, a);
  }
#else
  a.lo = 0; a.hi = BISECT_HI;
  void* args[] = {&a};
  hipError_t e = hipLaunchCooperativeKernel((void*)yoco_mega, dim3(grid_blocks), dim3(NTHREADS), args, SMEM_BYTES, stream);
  if (e != hipSuccess) fprintf(stderr, "cooperative launch failed: %s (grid %d)\n", hipGetErrorString(e), grid_blocks);
#endif
}
```

```cpp
#include <hip/hip_runtime.h>
#include <hip/hip_cooperative_groups.h>
#include <cstdio>
#include <cstdint>
namespace cg = cooperative_groups;

typedef unsigned short u16;
typedef short bf16x8 __attribute__((ext_vector_type(8)));
typedef float f32x4 __attribute__((ext_vector_type(4)));
typedef unsigned u32x4 __attribute__((ext_vector_type(4)));

#define T_TOK 65536
#define SEQL 2048
#define FHID 2816
#define NTHREADS 256
#define XCD_BAR_BYTES 16384
#define SMEM_BYTES 74240
#ifndef ABL_A
#define ABL_A 1.f
#endif
#ifndef ABL_B
#define ABL_B 1.f
#endif
#ifndef ABL_F
#define ABL_F 1.f
#endif
#define PREP_TILES (1024 + 512 + 384 + 256 + 16 + 576 + 512 + 5632 + 2816)

constexpr size_t OFF_W_AIN  = 0;
constexpr size_t OFF_W_GATE = OFF_W_AIN  + (size_t)2 * 2048 * 1024 * 2;
constexpr size_t OFF_W_AOUT = OFF_W_GATE + (size_t)64 * 128 * 128 * 2;
constexpr size_t OFF_W_KV   = OFF_W_AOUT + (size_t)2 * 1024 * 1024 * 2;
constexpr size_t OFF_W_C1   = OFF_W_KV   + (size_t)1536 * 1024 * 2;
constexpr size_t OFF_W_C2   = OFF_W_C1   + (size_t)2 * 256 * 2048 * 2;
constexpr size_t OFF_W_BIN  = OFF_W_C2   + (size_t)2 * 128 * 256 * 2;
constexpr size_t OFF_W_BOUT = OFF_W_BIN  + (size_t)2 * 1152 * 1024 * 2;
constexpr size_t OFF_W_FIN  = OFF_W_BOUT + (size_t)2 * 1024 * 1024 * 2;
constexpr size_t OFF_W_FOUT = OFF_W_FIN  + (size_t)4 * 5632 * 1024 * 2;
constexpr size_t OFF_ROPE   = OFF_W_FOUT + (size_t)4 * 1024 * 2816 * 2;
constexpr size_t OFF_PB     = OFF_ROPE   + (size_t)2048 * 32 * 2 * 4;
constexpr size_t OFF_U      = OFF_PB     + (size_t)2 * 16 * 256 * 4;
constexpr size_t OFF_BUFA   = OFF_U      + (size_t)T_TOK * 1024 * 2;
constexpr size_t OFF_KC     = OFF_BUFA   + (size_t)T_TOK * FHID * 2;
constexpr size_t OFF_VC     = OFF_KC     + (size_t)T_TOK * 256 * 2;
constexpr size_t OFF_KS     = OFF_VC     + (size_t)T_TOK * 256 * 2;
constexpr size_t OFF_KW     = OFF_KS     + (size_t)T_TOK * 256 * 2;
constexpr size_t OFF_VST    = OFF_KW     + (size_t)T_TOK * 256 * 2;
constexpr size_t OFF_VWT    = OFF_VST    + (size_t)T_TOK * 256 * 2;
constexpr size_t OFF_KCMP   = OFF_VWT    + (size_t)T_TOK * 256 * 2;
constexpr size_t OFF_VCMPT  = OFF_KCMP   + (size_t)128 * 128 * 64 * 2;
constexpr size_t OFF_HID    = OFF_VCMPT  + (size_t)128 * 64 * 128 * 2;
constexpr size_t OFF_GATES  = OFF_HID    + (size_t)2 * 16256 * 256 * 2;
#define OFF_FLAG (OFF_GATES + (size_t)T_TOK * 48 * 4)
#define OFF_BAR (OFF_FLAG + 16384)
constexpr size_t WS_END     = OFF_GATES  + (size_t)T_TOK * 48 * 4 + 16384 + XCD_BAR_BYTES;

struct KArgs {
  const float* in[25];
  float* out;
  char* ws;
  int lo, hi;
};
enum { I_X = 0, I_ANORM, I_AWIN, I_ACONVW, I_ACONVB, I_AGATEW, I_AGATEB, I_ALAM, I_AWOUT, I_KVNORM, I_KVW, I_KNORM,
       I_CMPPOS, I_CMPW1, I_CMPB1, I_CMPW2, I_CMPB2, I_BNORM, I_BWIN, I_BGATEB, I_QNORM, I_BWOUT, I_FNORM, I_FWIN, I_FWOUT };

__device__ __forceinline__ unsigned pack2(float lo, float hi) { unsigned r; asm("v_cvt_pk_bf16_f32 %0, %1, %2" : "=v"(r) : "v"(lo), "v"(hi)); return r; }
__device__ __forceinline__ u16 f2bf(float f) { return (u16)pack2(f, f); }
__device__ __forceinline__ float bf2f(u16 h) { return __uint_as_float(((unsigned)h) << 16); }
__device__ __forceinline__ float sigmoidf_(float x) { return __builtin_amdgcn_rcpf(1.f + __expf(-x)); }
__device__ __forceinline__ float gelu_tanh(float x) { float u = 0.7978845608028654f * (x + 0.044715f * x * x * x); return x * __builtin_amdgcn_rcpf(1.f + __expf(-2.f * u)); }
__device__ __forceinline__ f32x4 mfma16(bf16x8 a, bf16x8 b, f32x4 c) { return __builtin_amdgcn_mfma_f32_16x16x32_bf16(a, b, c, 0, 0, 0); }

__device__ __forceinline__ int otid() { int t = threadIdx.x; asm volatile("" : "+v"(t)); return t; }

#define LDS_AS __attribute__((address_space(3)))
struct APlain {
  const u16* A; int lda;
  __device__ __forceinline__ const u16* rowptr(int row) const { return A + (size_t)row * lda; }
  __device__ __forceinline__ int kstride() const { return 64; }
};
struct ACmp {
  const u16* kc;
  __device__ __forceinline__ const u16* rowptr(int row) const {
    const int g = row & 3, bc = row >> 2, b = bc / 127, c = bc - b * 127;
    return kc + ((size_t)(b * SEQL + c * 16) * 256 + g * 64);
  }
  __device__ __forceinline__ int kstride() const { return 256; }
};

template <class AP, class EP>
__device__ __forceinline__ void gemm_tile(const AP& ap, const u16* __restrict__ Bt, int K, int m0, int n0, const EP& ep, char* smem) {
  const int tid = otid(), lane = tid & 63, w = tid >> 6, wm = w >> 1, wn = w & 1, c16 = lane & 15, quad = lane >> 4;
  const int nk = K >> 6;
  const int srow = lane >> 2;
  const int scol = (w & 1) * 32 + ((((lane & 3) * 16) ^ ((lane >> 5) << 5)) >> 1);
  const u16* ga[4]; const u16* gb[4];
#pragma unroll
  for (int p = 0; p < 4; ++p) {
    const int R = ((w >> 1) + 2 * p) * 16 + srow;
    ga[p] = ap.rowptr(m0 + R) + scol;
    gb[p] = Bt + (size_t)(n0 + R) * K + scol;
  }
  const int kstr = ap.kstride();
  const int lofs = (c16 * 64 + quad * 16) ^ ((c16 >> 3) << 5);
  f32x4 acc[4][4];
#pragma unroll
  for (int i = 0; i < 4; ++i)
#pragma unroll
    for (int j = 0; j < 4; ++j) acc[i][j] = f32x4{0.f, 0.f, 0.f, 0.f};

#define GSTAGE(buf_, kt_)                                                                                                        \
  _Pragma("unroll") for (int p = 0; p < 4; ++p) {                                                                                \
    __builtin_amdgcn_global_load_lds((const unsigned*)(ga[p] + (size_t)(kt_) * kstr),                                            \
                                     (LDS_AS unsigned*)(smem + (buf_) * 32768 + w * 1024 + p * 4096), 16, 0, 0);                 \
    __builtin_amdgcn_global_load_lds((const unsigned*)(gb[p] + (size_t)(kt_) * 64),                                              \
                                     (LDS_AS unsigned*)(smem + (buf_) * 32768 + 16384 + w * 1024 + p * 4096), 16, 0, 0);         \
  }
  GSTAGE(0, 0);
  asm volatile("s_waitcnt vmcnt(0)" ::: "memory");
  __syncthreads();
  for (int kt = 0; kt < nk; ++kt) {
    const int cur = kt & 1;
    if (kt + 1 < nk) { GSTAGE(cur ^ 1, kt + 1); }
    const char* pa = smem + cur * 32768 + (wm * 8) * 1024 + lofs;
    const char* pb = smem + cur * 32768 + 16384 + (wn * 8) * 1024 + lofs;
#pragma unroll
    for (int ks = 0; ks < 2; ++ks) {
      bf16x8 af[4], bfr[4];
#pragma unroll
      for (int i = 0; i < 4; ++i) { af[i] = *(const bf16x8*)(pa + (i * 2 + ks) * 1024); bfr[i] = *(const bf16x8*)(pb + (i * 2 + ks) * 1024); }
      __builtin_amdgcn_s_setprio(1);
#pragma unroll
      for (int i = 0; i < 4; ++i)
#pragma unroll
        for (int j = 0; j < 4; ++j) acc[i][j] = EP::TR ? mfma16(bfr[j], af[i], acc[i][j]) : mfma16(af[i], bfr[j], acc[i][j]);
      __builtin_amdgcn_s_setprio(0);
    }
    __builtin_amdgcn_sched_barrier(0);
    asm volatile("s_waitcnt vmcnt(0)" ::: "memory");
    __syncthreads();
  }
#undef GSTAGE
  ep(acc, m0 + wm * 64, n0 + wn * 64, lane);
}

__device__ __forceinline__ bool super_tile(int it, int mtiles, int ntiles, int SN, int& m, int& n) {
  const int nbx = gridDim.x >> 3, x = blockIdx.x & 7, lb = blockIdx.x >> 3;
  const int SM = nbx / SN, scols = (ntiles + SN - 1) / SN;
  const int s = x + 8 * it, sr = s / scols, sc = s - sr * scols;
  m = sr * SM + (lb % SM); n = sc * SN + (lb / SM);
  return (lb < SM * SN) && (m < mtiles) && (n < ntiles);
}
__device__ __forceinline__ int super_iters(int mtiles, int ntiles, int SN) {
  const int nbx = gridDim.x >> 3, SM = nbx / SN;
  const int nsuper = ((ntiles + SN - 1) / SN) * ((mtiles + SM - 1) / SM);
  return (nsuper + 7) >> 3;
}
template <class AP, class EP>
__device__ __forceinline__ void gemm_phase(const AP& ap, const u16* Bt, int K, int mtiles, int ntiles, const EP& ep, char* smem, int SN) {
  const int iters = super_iters(mtiles, ntiles, SN);
  for (int it = 0; it < iters; ++it) {
    int m, n;
    if (super_tile(it, mtiles, ntiles, SN, m, n)) gemm_tile(ap, Bt, K, m * 128, n * 128, ep, smem);
  }
}


__device__ __forceinline__ void head_norm_rope(float (&v)[4], const float* __restrict__ gain, const float* __restrict__ rope, int pos, int c16, float outscale) {
  float ss = v[0] * v[0] + v[1] * v[1] + v[2] * v[2] + v[3] * v[3];
  ss += __shfl_xor(ss, 1); ss += __shfl_xor(ss, 2); ss += __shfl_xor(ss, 4); ss += __shfl_xor(ss, 8);
  const float rs = rsqrtf(ss * (1.f / 64.f) + 1e-6f) * outscale;
  const float y0 = v[0] * rs * gain[c16], y1 = v[1] * rs * gain[16 + c16], y2 = v[2] * rs * gain[32 + c16], y3 = v[3] * rs * gain[48 + c16];
  const float2 cs0 = *(const float2*)(rope + ((size_t)pos * 32 + c16) * 2);
  const float2 cs1 = *(const float2*)(rope + ((size_t)pos * 32 + 16 + c16) * 2);
  v[0] = y0 * cs0.x - y2 * cs0.y; v[2] = y0 * cs0.y + y2 * cs0.x;
  v[1] = y1 * cs1.x - y3 * cs1.y; v[3] = y1 * cs1.y + y3 * cs1.x;
}

struct EpAin {
  static constexpr bool TR = true;
  u16* y; u16* zr;
  __device__ __forceinline__ void operator()(f32x4 (&acc)[4][4], int mb, int nb, int lane) const {
    const int c16 = lane & 15, quad = lane >> 4;
#pragma unroll
    for (int mi = 0; mi < 4; ++mi)
#pragma unroll
      for (int ni = 0; ni < 4; ++ni) {
        const int row = mb + mi * 16 + c16, col = nb + ni * 16 + quad * 4;
        uint2 pk;
        if (nb < 1024) {
          pk.x = pack2(gelu_tanh(acc[mi][ni][0]), gelu_tanh(acc[mi][ni][1])); pk.y = pack2(gelu_tanh(acc[mi][ni][2]), gelu_tanh(acc[mi][ni][3]));
          *(uint2*)(y + (size_t)row * 1024 + col) = pk;
        } else {
          pk.x = pack2(acc[mi][ni][0], acc[mi][ni][1]); pk.y = pack2(acc[mi][ni][2], acc[mi][ni][3]);
          *(uint2*)(zr + (size_t)row * 1024 + col - 1024) = pk;
        }
      }
  }
};
struct EpRes {
  static constexpr bool TR = true;
  const float* res; float* out; float sc;
  __device__ __forceinline__ void operator()(f32x4 (&acc)[4][4], int mb, int nb, int lane) const {
    const int c16 = lane & 15, quad = lane >> 4;
#pragma unroll
    for (int mi = 0; mi < 4; ++mi)
#pragma unroll
      for (int ni = 0; ni < 4; ++ni) {
        const size_t idx = (size_t)(mb + mi * 16 + c16) * 1024 + nb + ni * 16 + quad * 4;
        const float4 r = *(const float4*)(res + idx);
        float4 o; o.x = r.x + sc * acc[mi][ni][0]; o.y = r.y + sc * acc[mi][ni][1]; o.z = r.z + sc * acc[mi][ni][2]; o.w = r.w + sc * acc[mi][ni][3];
        *(float4*)(out + idx) = o;
      }
  }
};
struct EpFfn1 {
  static constexpr bool TR = true;
  u16* act;
  __device__ __forceinline__ void operator()(f32x4 (&acc)[4][4], int mb, int nb, int lane) const {
    const int c16 = lane & 15, quad = lane >> 4;
    const int hb = (nb >> 6) * 32;
#pragma unroll
    for (int mi = 0; mi < 4; ++mi)
#pragma unroll
      for (int ni = 0; ni < 2; ++ni) {
        float v[4];
#pragma unroll
        for (int jj = 0; jj < 4; ++jj) { const float g = acc[mi][ni][jj], u = acc[mi][ni + 2][jj]; v[jj] = g * u * __builtin_amdgcn_rcpf(1.f + __expf(-g)); }
        uint2 pk; pk.x = pack2(v[0], v[1]); pk.y = pack2(v[2], v[3]);
        *(uint2*)(act + (size_t)(mb + mi * 16 + c16) * FHID + hb + ni * 16 + quad * 4) = pk;
      }
  }
};
struct EpKV {
  static constexpr bool TR = false;
  char* ws; const float* knorm; const float* rope;
  __device__ __forceinline__ void operator()(f32x4 (&acc)[4][4], int mb, int nb, int lane) const {
    const int c16 = lane & 15, quad = lane >> 4;
    const int j6 = nb >> 8, g = (nb & 255) >> 6;
    const int b = mb / SEQL, sb = mb - b * SEQL;
    if (j6 < 2) {
      u16* dst = (u16*)(ws + (j6 == 0 ? OFF_KC : OFF_VC));
#pragma unroll
      for (int mi = 0; mi < 4; ++mi)
#pragma unroll
        for (int ni = 0; ni < 4; ++ni)
#pragma unroll
          for (int j = 0; j < 4; ++j)
            dst[(size_t)(mb + mi * 16 + quad * 4 + j) * 256 + g * 64 + ni * 16 + c16] = f2bf(acc[mi][ni][j]);
    } else if (j6 == 2 || j6 == 4) {
      u16* dst = (u16*)(ws + (j6 == 2 ? OFF_KS : OFF_KW));
      const float* gain = knorm + (j6 == 2 ? 64 : 128);
#pragma unroll
      for (int mi = 0; mi < 4; ++mi)
#pragma unroll
        for (int j = 0; j < 4; ++j) {
          const int s = sb + mi * 16 + quad * 4 + j;
          float v[4] = {acc[mi][0][j], acc[mi][1][j], acc[mi][2][j], acc[mi][3][j]};
          head_norm_rope(v, gain, rope, s, c16, 1.f);
#pragma unroll
          for (int ni = 0; ni < 4; ++ni) dst[((size_t)(b * 4 + g) * SEQL + s) * 64 + ni * 16 + c16] = f2bf(v[ni]);
        }
    } else {
      u16* dst = (u16*)(ws + (j6 == 3 ? OFF_VST : OFF_VWT));
#pragma unroll
      for (int mi = 0; mi < 4; ++mi)
#pragma unroll
        for (int ni = 0; ni < 4; ++ni) {
          const int d = ni * 16 + c16, s = sb + mi * 16 + quad * 4;
          uint2 pk; pk.x = pack2(acc[mi][ni][0], acc[mi][ni][1]); pk.y = pack2(acc[mi][ni][2], acc[mi][ni][3]);
          *(uint2*)(dst + ((size_t)(b * 4 + g) * 64 + d) * SEQL + s) = pk;
        }
    }
  }
};
struct EpCmp1 {
  static constexpr bool TR = false;
  u16* hid; const float* pbpart; const float* b1;
  __device__ __forceinline__ void operator()(f32x4 (&acc)[4][4], int mb, int nb, int lane) const {
    const int c16 = lane & 15, quad = lane >> 4;
#pragma unroll
    for (int ni = 0; ni < 4; ++ni) {
      const int col = nb + ni * 16 + c16;
      float pb = b1[col];
      for (int s = 0; s < 16; ++s) pb += pbpart[s * 256 + col];
#pragma unroll
      for (int mi = 0; mi < 4; ++mi)
#pragma unroll
        for (int j = 0; j < 4; ++j)
          hid[(size_t)(mb + mi * 16 + quad * 4 + j) * 256 + col] = f2bf(gelu_tanh(acc[mi][ni][j] + pb));
    }
  }
};
struct EpCmp2 {
  static constexpr bool TR = false;
  char* ws; int kv; const float* b2; const float* knorm; const float* rope;
  __device__ __forceinline__ void operator()(f32x4 (&acc)[4][4], int mb, int nb, int lane) const {
    if (nb & 64) return;
    const int c16 = lane & 15, quad = lane >> 4;
    float bb[4];
#pragma unroll
    for (int ni = 0; ni < 4; ++ni) bb[ni] = b2[ni * 16 + c16];
#pragma unroll
    for (int mi = 0; mi < 4; ++mi)
#pragma unroll
      for (int j = 0; j < 4; ++j) {
        const int row = mb + mi * 16 + quad * 4 + j;
        const int g = row & 3, bc = row >> 2, b = bc / 127, c = bc - b * 127;
        float v[4] = {acc[mi][0][j] + bb[0], acc[mi][1][j] + bb[1], acc[mi][2][j] + bb[2], acc[mi][3][j] + bb[3]};
        if (kv == 0) {
          head_norm_rope(v, knorm, rope, c * 16 + 31, c16, 1.f);
          u16* dst = (u16*)(ws + OFF_KCMP) + ((size_t)(b * 4 + g) * 128 + c) * 64;
#pragma unroll
          for (int ni = 0; ni < 4; ++ni) dst[ni * 16 + c16] = f2bf(v[ni]);
        } else {
          u16* dst = (u16*)(ws + OFF_VCMPT) + (size_t)(b * 4 + g) * 64 * 128 + c;
#pragma unroll
          for (int ni = 0; ni < 4; ++ni) dst[(size_t)(ni * 16 + c16) * 128] = f2bf(v[ni]);
        }
      }
  }
};
__device__ __forceinline__ void head_norm_rope_t(float (&v)[4][4], const float* __restrict__ gain, const float* __restrict__ rope, int pos, int quad, float outscale) {
  float ss = 0.f;
#pragma unroll
  for (int ni = 0; ni < 4; ++ni)
#pragma unroll
    for (int jj = 0; jj < 4; ++jj) ss += v[ni][jj] * v[ni][jj];
  ss += __shfl_xor(ss, 16); ss += __shfl_xor(ss, 32);
  const float rs = rsqrtf(ss * (1.f / 64.f) + 1e-6f) * outscale;
#pragma unroll
  for (int ni = 0; ni < 2; ++ni) {
    const int d = ni * 16 + quad * 4;
    const float4 g1 = *(const float4*)(gain + d), g2 = *(const float4*)(gain + d + 32);
    const float4 csa = *(const float4*)(rope + ((size_t)pos * 32 + d) * 2), csb = *(const float4*)(rope + ((size_t)pos * 32 + d) * 2 + 4);
    const float g1a[4] = {g1.x, g1.y, g1.z, g1.w}, g2a[4] = {g2.x, g2.y, g2.z, g2.w};
    const float cc[4] = {csa.x, csa.z, csb.x, csb.z}, sn[4] = {csa.y, csa.w, csb.y, csb.w};
#pragma unroll
    for (int jj = 0; jj < 4; ++jj) {
      const float y1 = v[ni][jj] * rs * g1a[jj], y2 = v[ni + 2][jj] * rs * g2a[jj];
      v[ni][jj] = y1 * cc[jj] - y2 * sn[jj];
      v[ni + 2][jj] = y1 * sn[jj] + y2 * cc[jj];
    }
  }
}
struct EpQ {
  static constexpr bool TR = true;
  u16* q; float* gates; const float* qnorm; const float* gate_b; const float* rope;
  __device__ __forceinline__ void operator()(f32x4 (&acc)[4][4], int mb, int nb, int lane) const {
    const int c16 = lane & 15, quad = lane >> 4;
    if (nb < 1024) {
      const float osc = 0.125f * 1.4426950408889634f;
#pragma unroll
      for (int mi = 0; mi < 4; ++mi) {
        const int row = mb + mi * 16 + c16;
        float v[4][4];
#pragma unroll
        for (int ni = 0; ni < 4; ++ni)
#pragma unroll
          for (int jj = 0; jj < 4; ++jj) v[ni][jj] = acc[mi][ni][jj];
        head_norm_rope_t(v, qnorm, rope, row & (SEQL - 1), quad, osc);
#pragma unroll
        for (int ni = 0; ni < 4; ++ni) {
          uint2 pk; pk.x = pack2(v[ni][0], v[ni][1]); pk.y = pack2(v[ni][2], v[ni][3]);
          *(uint2*)(q + (size_t)row * 1024 + nb + ni * 16 + quad * 4) = pk;
        }
      }
    } else if (nb == 1024) {
#pragma unroll
      for (int ni = 0; ni < 3; ++ni) {
        const int gi = ni * 16 + quad * 4;
        const float4 gb = *(const float4*)(gate_b + gi);
#pragma unroll
        for (int mi = 0; mi < 4; ++mi) {
          float4 o;
          o.x = sigmoidf_(acc[mi][ni][0] + gb.x); o.y = sigmoidf_(acc[mi][ni][1] + gb.y);
          o.z = sigmoidf_(acc[mi][ni][2] + gb.z); o.w = sigmoidf_(acc[mi][ni][3] + gb.w);
          *(float4*)(gates + (size_t)(mb + mi * 16 + c16) * 48 + gi) = o;
        }
      }
    }
  }
};

#define XB_TMO      128
#define XB_XCNT(j)  (256  + 64 * (j))
#define XB_XSUB(j)  (1280 + 64 * (j))
#define XB_XGEN(j)  (2304 + 64 * (j))
#define XB_TOP      3328
#define XB_TOPGEN   3392
#define XCD_BAR_WORDS 3456
#define XB_SPIN_CAP (1u << 22)
__device__ __forceinline__ unsigned xb_ld(unsigned* p)              { return __hip_atomic_load(p, __ATOMIC_RELAXED, __HIP_MEMORY_SCOPE_AGENT); }
__device__ __forceinline__ unsigned xb_add(unsigned* p, unsigned v) { return __hip_atomic_fetch_add(p, v, __ATOMIC_RELAXED, __HIP_MEMORY_SCOPE_AGENT); }
__device__ __forceinline__ unsigned xb_xcc_id() { return (unsigned)__builtin_amdgcn_s_getreg((3 << 11) | 20) & 0xFu; }
#define XB_SPIN(cond, bar) do { unsigned _sp = 0; while (cond) { __builtin_amdgcn_s_sleep(1); \
    if ((++_sp & 255u) == 0u) { if (xb_ld(&(bar)[XB_TMO])) break; if (_sp > XB_SPIN_CAP) { atomicAdd(&(bar)[XB_TMO], 1u); break; } } } } while (0)
struct XcdBarrier { unsigned* bar; unsigned x; volatile LDS_AS unsigned* st; };
__device__ __forceinline__ XcdBarrier xcd_barrier_post(unsigned* bar, volatile LDS_AS unsigned* st) {
  XcdBarrier b; b.bar = bar; b.x = xb_xcc_id(); b.st = st;
  if (threadIdx.x == 0) (void)xb_add(&bar[XB_XCNT(b.x)], 1u);
  return b;
}
__device__ __forceinline__ void xcd_barrier_complete(unsigned* bar, unsigned x, unsigned& nloc, unsigned& nx) {
  const unsigned G = gridDim.x * gridDim.y * gridDim.z;
  unsigned sum, cnt, mine, sp = 0u;
  for (;;) {
    sum = 0u; cnt = 0u; mine = 0u;
#pragma unroll
    for (unsigned j = 0; j < 16; ++j) { const unsigned c = xb_ld(&bar[XB_XCNT(j)]); sum += c; cnt += (c > 0u) ? 1u : 0u; mine = (j == x) ? c : mine; }
    if (sum == G) break;
    __builtin_amdgcn_s_sleep(1);
    if ((++sp & 255u) == 0u) { if (xb_ld(&bar[XB_TMO])) break; if (sp > XB_SPIN_CAP) { atomicAdd(&bar[XB_TMO], 1u); break; } }
  }
  nloc = mine > 0u ? mine : 1u; nx = cnt > 0u ? cnt : 1u;
}
__device__ __forceinline__ void xcd_barrier(const XcdBarrier& b) {
  asm volatile("s_waitcnt vmcnt(0)" ::: "memory");
  __syncthreads();
  if (threadIdx.x == 0) {
    unsigned* bar = b.bar;
    __builtin_amdgcn_s_waitcnt(0);
    unsigned nloc = b.st[0], nx = b.st[1];
    if (nloc == 0u) { xcd_barrier_complete(bar, b.x, nloc, nx); b.st[0] = nloc; b.st[1] = nx; }
    const unsigned old = xb_add(&bar[XB_XSUB(b.x)], 1u);
    const unsigned gen = old / nloc;
    if (old + 1u == (gen + 1u) * nloc) {
      __builtin_amdgcn_fence(__ATOMIC_RELEASE, "agent");
      asm volatile("s_waitcnt vmcnt(0)" ::: "memory");
      const unsigned og = xb_add(&bar[XB_TOP], 1u);
      const unsigned tg = og / nx;
      if (og + 1u == (tg + 1u) * nx) xb_add(&bar[XB_TOPGEN], 1u);
      else XB_SPIN(xb_ld(&bar[XB_TOPGEN]) == tg, bar);
      __builtin_amdgcn_fence(__ATOMIC_ACQUIRE, "agent");
      xb_add(&bar[XB_XGEN(b.x)], 1u);
      asm volatile("s_waitcnt vmcnt(0)" ::: "memory");
    } else {
      XB_SPIN(xb_ld(&bar[XB_XGEN(b.x)]) == gen, bar);
      __builtin_amdgcn_fence(__ATOMIC_ACQUIRE, "agent");
      asm volatile("s_waitcnt vmcnt(0)" ::: "memory");
    }
  }
  __syncthreads();
}

__device__ __forceinline__ void norm_phase(const float* __restrict__ h, const float* __restrict__ g, u16* __restrict__ u) {
  const int tidn = otid();
  const int lane = tidn & 63;
  const int gw = blockIdx.x * 4 + (tidn >> 6), nw = gridDim.x * 4;
  float4 gv[4];
#pragma unroll
  for (int i = 0; i < 4; ++i) gv[i] = *(const float4*)(g + i * 256 + lane * 4);
  for (int row = gw; row < T_TOK; row += nw) {
    const float* hr = h + (size_t)row * 1024;
    float4 v[4];
    float ss = 0.f;
#pragma unroll
    for (int i = 0; i < 4; ++i) { v[i] = *(const float4*)(hr + i * 256 + lane * 4); ss += v[i].x * v[i].x + v[i].y * v[i].y + v[i].z * v[i].z + v[i].w * v[i].w; }
#pragma unroll
    for (int o = 32; o >= 1; o >>= 1) ss += __shfl_xor(ss, o);
    const float rs = rsqrtf(ss * (1.f / 1024.f) + 1e-6f);
#pragma unroll
    for (int i = 0; i < 4; ++i) {
      uint2 pk; pk.x = pack2(v[i].x * rs * gv[i].x, v[i].y * rs * gv[i].y); pk.y = pack2(v[i].z * rs * gv[i].z, v[i].w * rs * gv[i].w);
      *(uint2*)(u + (size_t)row * 1024 + i * 256 + lane * 4) = pk;
    }
  }
}

__device__ __forceinline__ void do_transpose(const float* __restrict__ src, u16* __restrict__ dst, int K, int N, int Nd, int mode, int t, char* smem) {
  float* tile = (float*)smem;
  const int tid = otid();
  const int ktn = K >> 6, tpb = ktn * (Nd >> 6);
  const int bi = t / tpb, r = t - bi * tpb, nt = r / ktn, kt = r - nt * ktn;
  const float* sb = src + (size_t)bi * K * N;
  u16* db = dst + (size_t)bi * Nd * K;
  __syncthreads();
#pragma unroll 4
  for (int i = 0; i < 16; ++i) {
    const int e = tid + i * 256, kk = e >> 6, nn = e & 63;
    const int n1 = nt * 64 + nn;
    int sc = n1;
    if (mode == 1) { const int blk = n1 >> 6, rr = n1 & 63; const int hid = blk * 32 + (rr & 31); sc = (rr < 32) ? hid : (FHID + hid); }
    tile[kk * 65 + nn] = (sc < N) ? sb[(size_t)(kt * 64 + kk) * N + sc] : 0.f;
  }
  __syncthreads();
#pragma unroll 4
  for (int i = 0; i < 16; ++i) {
    const int e = tid + i * 256, nn = e >> 6, kk = e & 63;
    db[(size_t)(nt * 64 + nn) * K + kt * 64 + kk] = f2bf(tile[kk * 65 + nn]);
  }
}

__device__ __forceinline__ void prep_phase(const KArgs& a, char* smem) {
  char* ws = a.ws;
  constexpr int TOTAL = PREP_TILES;
  for (int tile = blockIdx.x; tile < TOTAL; tile += gridDim.x) {
    int t = tile;
#define JOB(S, D, K_, N_, ND_, B_, M_)                                                               \
    { constexpr int cnt = (B_) * ((K_) / 64) * ((ND_) / 64);                                         \
      if (t >= 0 && t < cnt) do_transpose((S), (u16*)(ws + (D)), (K_), (N_), (ND_), (M_), t, smem);  \
      t -= cnt; }
    JOB(a.in[I_AWIN],   OFF_W_AIN,  1024, 2048, 2048, 2, 0)
    JOB(a.in[I_AWOUT],  OFF_W_AOUT, 1024, 1024, 1024, 2, 0)
    JOB(a.in[I_KVW],    OFF_W_KV,   1024, 1536, 1536, 1, 0)
    JOB(a.in[I_CMPW1],  OFF_W_C1,   2048, 256,  256,  2, 0)
    JOB(a.in[I_CMPW2],  OFF_W_C2,   256,  64,   128,  2, 0)
    JOB(a.in[I_BWIN],   OFF_W_BIN,  1024, 1072, 1152, 2, 0)
    JOB(a.in[I_BWOUT],  OFF_W_BOUT, 1024, 1024, 1024, 2, 0)
    JOB(a.in[I_FWIN],   OFF_W_FIN,  1024, 5632, 5632, 4, 1)
    JOB(a.in[I_FWOUT],  OFF_W_FOUT, 2816, 1024, 1024, 4, 0)
#undef JOB
  }
  const int tidp = otid();
  const int gt = blockIdx.x * NTHREADS + tidp, ng = gridDim.x * NTHREADS;
  for (int i = gt; i < 2048; i += ng) ((unsigned*)(ws + OFF_FLAG))[i] = 0u;
  {
    const float* gsrc = (const float*)(ws + OFF_HID);
    u16* gdst = (u16*)(ws + OFF_W_GATE);
    for (int i = gt; i < 2 * 2048 * 128; i += ng) {
      const int Lg = i >> 18, n = (i >> 7) & 2047, k = i & 127;
      const int hd = n >> 8, rp = n & 255, half = rp >> 7, q = (rp & 127) >> 6, rr = rp & 63, gate = rr >> 5;
      const int chl = half * 64 + q * 32 + (rr & 31);
      gdst[i] = f2bf(gsrc[((size_t)((Lg * 2 + gate) * 8 + hd) * 128 + k) * 128 + chl]);
    }
  }
  float* rope = (float*)(ws + OFF_ROPE);
  for (int i = gt; i < 2048 * 32; i += ng) {
    const int pos = i >> 5, fi = i & 31;
    const double freq = exp2(-(double)fi * (13.287712379549449 / 32.0));
    const double ang = (double)pos * freq;
    const double n = rint(ang * 0.15915494309189535);
    const float r = (float)(ang - n * 6.283185307179586);
    rope[2 * i] = cosf(r); rope[2 * i + 1] = sinf(r);
  }
  float* pb = (float*)(ws + OFF_PB);
  for (int it = blockIdx.x; it < 32; it += gridDim.x) {
    const int kv = it >> 4, ks = it & 15, n = tidp;
    const float* pos = a.in[I_CMPPOS] + kv * 2048 + ks * 128;
    const float* w1 = a.in[I_CMPW1] + ((size_t)kv * 2048 + ks * 128) * 256 + n;
    float s = 0.f;
    for (int k = 0; k < 128; ++k) s += pos[k] * w1[(size_t)k * 256];
    pb[(kv * 16 + ks) * 256 + n] = s;
  }
  u16* kcmp = (u16*)(ws + OFF_KCMP); u16* vcmpt = (u16*)(ws + OFF_VCMPT);
  for (int i = gt; i < 128 * 64; i += ng) {
    const int bg = i >> 6, d = i & 63;
    kcmp[((size_t)bg * 128 + 127) * 64 + d] = 0;
    vcmpt[((size_t)bg * 64 + d) * 128 + 127] = 0;
  }
}

__device__ __forceinline__ void conv_phase(const KArgs& a, int L) {
  const u16* ZR = (const u16*)(a.ws + OFF_BUFA) + (size_t)T_TOK * 1024;
  u16* XR = (u16*)(a.ws + OFF_U);
  const int gt = blockIdx.x * NTHREADS + otid(), ng = gridDim.x * NTHREADS;
  const int ch0 = (gt & 127) * 8;
  float cw[4][8], cb[8];
#pragma unroll
  for (int c = 0; c < 8; ++c) {
    cb[c] = a.in[I_ACONVB][(size_t)L * 1024 + ch0 + c];
#pragma unroll
    for (int k = 0; k < 4; ++k) cw[k][c] = a.in[I_ACONVW][(size_t)(L * 4 + k) * 1024 + ch0 + c];
  }
  for (int unit = gt; unit < (T_TOK / 16) * 128; unit += ng) {
    const int t0 = (unit >> 7) * 16, s0 = t0 & (SEQL - 1);
    const u16* src = ZR + (size_t)t0 * 1024 + ch0;
    uint4 rows[19];
#pragma unroll
    for (int r = 0; r < 19; ++r) {
      if (s0 + r - 3 >= 0) rows[r] = *(const uint4*)(src + (ptrdiff_t)(r - 3) * 1024);
      else rows[r] = make_uint4(0u, 0u, 0u, 0u);
    }
#pragma unroll
    for (int i = 0; i < 16; ++i) {
      float o[8];
#pragma unroll
      for (int c = 0; c < 8; ++c) o[c] = cb[c];
#pragma unroll
      for (int k = 0; k < 4; ++k) {
        const uint4 v = rows[i + k];
        const unsigned wv[4] = {v.x, v.y, v.z, v.w};
#pragma unroll
        for (int c = 0; c < 4; ++c) {
          o[2 * c] += cw[k][2 * c] * __uint_as_float(wv[c] << 16);
          o[2 * c + 1] += cw[k][2 * c + 1] * __uint_as_float(wv[c] & 0xffff0000u);
        }
      }
      uint4 pk; pk.x = pack2(o[0], o[1]); pk.y = pack2(o[2], o[3]); pk.z = pack2(o[4], o[5]); pk.w = pack2(o[6], o[7]);
      *(uint4*)(XR + (size_t)(t0 + i) * 1024 + ch0) = pk;
    }
  }
}

struct EpGate {
  static constexpr bool TR = false;
  const u16* xr; u16* la; u16* bv; const float* gb; const float* lam;
  __device__ __forceinline__ void operator()(f32x4 (&acc)[4][4], int mb, int nb, int lane) const {
    const int c16 = lane & 15, quad = lane >> 4;
    const int chb = (nb >> 8) * 128 + ((nb >> 7) & 1) * 64 + ((nb >> 6) & 1) * 32;
#pragma unroll
    for (int ni = 0; ni < 2; ++ni) {
      const int ch = chb + ni * 16 + c16;
      const float g0b = gb[ch], g1b = gb[1024 + ch];
      const float cl = -8.f * log1pf(expf(-lam[ch]));
#pragma unroll
      for (int mi = 0; mi < 4; ++mi)
#pragma unroll
        for (int j = 0; j < 4; ++j) {
          const size_t idx = (size_t)(mb + mi * 16 + quad * 4 + j) * 1024 + ch;
          const float r = sigmoidf_(acc[mi][ni][j] + g0b);
          const float ig = sigmoidf_(acc[mi][ni + 2][j] + g1b);
          const float l = cl * r;
          const float av = __expf(l);
          const float bt = sqrtf(fmaxf(1.f - av * av, 0.f)) * (ig * bf2f(xr[idx]));
          la[idx] = f2bf(l); bv[idx] = f2bf(bt);
        }
    }
  }
};

__device__ __forceinline__ void gates_phase(const KArgs& a, int L, char* smem) {
  char* ws = a.ws;
  const u16* XR = (const u16*)(ws + OFF_U);
  EpGate ep{XR, (u16*)(ws + OFF_BUFA) + (size_t)T_TOK * 1024, (u16*)(ws + OFF_KC), a.in[I_AGATEB] + (size_t)L * 2048, a.in[I_ALAM] + (size_t)L * 1024};
  const u16* Bt = (const u16*)(ws + OFF_W_GATE) + (size_t)L * 2048 * 128;
  const int iters = super_iters(512, 16, 4);
  for (int it = 0; it < iters; ++it) {
    int m, n;
    if (super_tile(it, 512, 16, 4, m, n)) {
      APlain ap{XR + (n >> 1) * 128, 1024};
      gemm_tile(ap, Bt, 128, m * 128, n * 128, ep, smem);
    }
  }
}

__device__ __forceinline__ void scan_phase(const KArgs& a, char* smem) {
  float* sP = (float*)smem; float* sH = sP + 256;
  const int tid = otid(), lane = tid & 63, w = tid >> 6;
  const u16* Y = (const u16*)(a.ws + OFF_BUFA);
  const u16* LA = Y + (size_t)T_TOK * 1024;
  const u16* BV = (const u16*)(a.ws + OFF_KC);
  u16* YH = (u16*)(a.ws + OFF_U);
  for (int item = blockIdx.x; item < 512; item += gridDim.x) {
    const int b = item >> 4, ch = (item & 15) * 64 + lane;
    const size_t base = ((size_t)b * SEQL + w * 512) * 1024 + ch;
    float P = 1.f, H = 0.f;
    for (int t = 0; t < 512; t += 16) {
      u16 l8[16], b8[16];
#pragma unroll
      for (int i = 0; i < 16; ++i) { l8[i] = LA[base + (size_t)(t + i) * 1024]; b8[i] = BV[base + (size_t)(t + i) * 1024]; }
#pragma unroll
      for (int i = 0; i < 16; ++i) { const float av = __expf(bf2f(l8[i])); H = av * H + bf2f(b8[i]); P *= av; }
    }
    __syncthreads();
    sP[w * 64 + lane] = P; sH[w * 64 + lane] = H;
    __syncthreads();
    float h = 0.f;
    for (int s2 = 0; s2 < w; ++s2) h = sP[s2 * 64 + lane] * h + sH[s2 * 64 + lane];
    for (int t = 0; t < 512; t += 16) {
      u16 l8[16], b8[16], y8[16];
#pragma unroll
      for (int i = 0; i < 16; ++i) { const size_t idx = base + (size_t)(t + i) * 1024; l8[i] = LA[idx]; b8[i] = BV[idx]; y8[i] = Y[idx]; }
#pragma unroll
      for (int i = 0; i < 16; ++i) {
        h = __expf(bf2f(l8[i])) * h + bf2f(b8[i]);
        YH[base + (size_t)(t + i) * 1024] = f2bf(bf2f(y8[i]) * h);
      }
    }
  }
}

#define SM_SHIFT 8.0f
__device__ __forceinline__ void qk_tile(const u16* Ks, const bf16x8 (&qf)[2][2], f32x4 (&S)[4][2], int c16, int quad) {
#pragma unroll
  for (int mb = 0; mb < 4; ++mb) {
#pragma unroll
    for (int nb = 0; nb < 2; ++nb) S[mb][nb] = f32x4{-SM_SHIFT, -SM_SHIFT, -SM_SHIFT, -SM_SHIFT};
#pragma unroll
    for (int ks = 0; ks < 2; ++ks) {
      const bf16x8 kf = *(const bf16x8*)(Ks + (mb * 16 + c16) * 72 + ks * 32 + quad * 8);
#pragma unroll
      for (int nb = 0; nb < 2; ++nb) S[mb][nb] = mfma16(kf, qf[nb][ks], S[mb][nb]);
    }
  }
}
__device__ __forceinline__ void pv_tile(const u16* Vs, int koff, const f32x4 (&P)[4][2], f32x4 (&O)[4][2], int c16, int quad) {
#pragma unroll
  for (int kk = 0; kk < 2; ++kk) {
    bf16x8 pf[2];
#pragma unroll
    for (int nb = 0; nb < 2; ++nb) {
      u32x4 t;
      t.x = pack2(P[2 * kk][nb][0], P[2 * kk][nb][1]); t.y = pack2(P[2 * kk][nb][2], P[2 * kk][nb][3]);
      t.z = pack2(P[2 * kk + 1][nb][0], P[2 * kk + 1][nb][1]); t.w = pack2(P[2 * kk + 1][nb][2], P[2 * kk + 1][nb][3]);
      pf[nb] = __builtin_bit_cast(bf16x8, t);
    }
#pragma unroll
    for (int db = 0; db < 4; ++db) {
      const u16* vp = Vs + (db * 16 + c16) * 136 + koff + kk * 32 + quad * 4;
      const uint2 lo = *(const uint2*)vp, hi = *(const uint2*)(vp + 16);
      u32x4 t; t.x = lo.x; t.y = lo.y; t.z = hi.x; t.w = hi.y;
      const bf16x8 vf = __builtin_bit_cast(bf16x8, t);
#pragma unroll
      for (int nb = 0; nb < 2; ++nb) O[db][nb] = mfma16(vf, pf[nb], O[db][nb]);
    }
  }
}

template <bool NOMASK, class MaskF>
__device__ __forceinline__ void flash_step(const u16* Ks, const u16* Vs, const bf16x8 (&qf)[2][2], f32x4 (&O)[4][2], float (&m)[2], float (&l)[2],
                                           const MaskF& valid, int c16, int quad) {
  f32x4 S[4][2];
  qk_tile(Ks, qf, S, c16, quad);
#pragma unroll
  for (int nb = 0; nb < 2; ++nb) {
    float rs = 0.f;
#pragma unroll
    for (int mb = 0; mb < 4; ++mb)
#pragma unroll
      for (int j = 0; j < 4; ++j) {
        const float pv = (NOMASK || valid(nb, mb * 16 + j)) ? __builtin_amdgcn_exp2f(S[mb][nb][j]) : 0.f;
        S[mb][nb][j] = pv; rs += pv;
      }
    rs += __shfl_xor(rs, 16); rs += __shfl_xor(rs, 32);
    l[nb] += rs;
  }
  pv_tile(Vs, 0, S, O, c16, quad);
}

__device__ __forceinline__ void attn_phase(const KArgs& a, char* smem) {
  u16* Ks = (u16*)smem;
  u16* Vs = (u16*)(smem + 18432);
  float* impM = (float*)(smem + 35840);
  float* impT = (float*)(smem + 35840 + 16896);
  float* sc = (float*)(smem + 69632);
  unsigned* selm = (unsigned*)(smem + 73856);
  unsigned* anyj = selm + 32;
  const u16* Q = (const u16*)(a.ws + OFF_BUFA);
  u16* Oo = (u16*)(a.ws + OFF_BUFA) + (size_t)T_TOK * 1024;
  const float* gates = (const float*)(a.ws + OFF_GATES);
  const u16* kcmp = (const u16*)(a.ws + OFF_KCMP); const u16* vcmpt = (const u16*)(a.ws + OFF_VCMPT);
  const u16* ksl = (const u16*)(a.ws + OFF_KS); const u16* kwn = (const u16*)(a.ws + OFF_KW);
  const u16* vst = (const u16*)(a.ws + OFF_VST); const u16* vwt = (const u16*)(a.ws + OFF_VWT);

  for (int item = blockIdx.x; item < 8192; item += gridDim.x) {
    const int tid = otid(), lane = tid & 63, w = tid >> 6, c16 = lane & 15, quad = lane >> 4;
    const int qt = 63 - (item >> 7), bg = item & 127, b = bg >> 2, g = bg & 3;
    const int s0 = qt * 32, hq = g * 4 + w;
    const size_t tok0 = (size_t)b * SEQL + s0;
    bf16x8 qf[2][2];
#pragma unroll
    for (int nb = 0; nb < 2; ++nb)
#pragma unroll
      for (int ks = 0; ks < 2; ++ks) qf[nb][ks] = *(const bf16x8*)(Q + (tok0 + nb * 16 + c16) * 1024 + hq * 64 + ks * 32 + quad * 8);
    int tq[2]; tq[0] = s0 + c16; tq[1] = s0 + 16 + c16;
    f32x4 of[4][2];
#pragma unroll
    for (int db = 0; db < 4; ++db)
#pragma unroll
      for (int nb = 0; nb < 2; ++nb) of[db][nb] = f32x4{0.f, 0.f, 0.f, 0.f};

    __syncthreads();
    {
      const u16* kc = kcmp + (size_t)bg * 128 * 64;
      const u16* vc = vcmpt + (size_t)bg * 64 * 128;
#pragma unroll
      for (int i = 0; i < 4; ++i) {
        const int id = tid + i * 256;
        { const int r = id >> 3, c = id & 7; *(uint4*)(Ks + r * 72 + c * 8) = *(const uint4*)(kc + r * 64 + c * 8); }
        { const int r = id >> 4, c = id & 15; *(uint4*)(Vs + r * 136 + c * 8) = *(const uint4*)(vc + r * 128 + c * 8); }
      }
      if (tid < 32) selm[tid] = 0u;
      if (tid == 32) *anyj = 0u;
    }
    __syncthreads();
    {
      int cmax[2]; cmax[0] = ((tq[0] - 31) >> 4) - quad * 4; cmax[1] = ((tq[1] - 31) >> 4) - quad * 4;
      float lC[2] = {0.f, 0.f};
#pragma unroll
      for (int h = 0; h < 2; ++h) {
        f32x4 S[4][2];
        qk_tile(Ks + h * 64 * 72, qf, S, c16, quad);
#pragma unroll
        for (int nb = 0; nb < 2; ++nb) {
          float rs = 0.f;
#pragma unroll
          for (int mb = 0; mb < 4; ++mb)
#pragma unroll
            for (int j = 0; j < 4; ++j) rs += (h * 64 + mb * 16 + j <= cmax[nb]) ? __builtin_amdgcn_exp2f(S[mb][nb][j]) : 0.f;
          rs += __shfl_xor(rs, 16); rs += __shfl_xor(rs, 32);
          lC[nb] += rs;
        }
      }
      float invC[2]; invC[0] = (lC[0] > 0.f) ? 1.f / lC[0] : 0.f; invC[1] = (lC[1] > 0.f) ? 1.f / lC[1] : 0.f;
      f32x4 Oc[4][2];
#pragma unroll
      for (int db = 0; db < 4; ++db)
#pragma unroll
        for (int nb = 0; nb < 2; ++nb) Oc[db][nb] = f32x4{0.f, 0.f, 0.f, 0.f};
#pragma unroll
      for (int h = 0; h < 2; ++h) {
        f32x4 S[4][2];
        qk_tile(Ks + h * 64 * 72, qf, S, c16, quad);
#pragma unroll
        for (int nb = 0; nb < 2; ++nb)
#pragma unroll
          for (int mb = 0; mb < 4; ++mb) {
#pragma unroll
            for (int j = 0; j < 4; ++j)
              S[mb][nb][j] = (h * 64 + mb * 16 + j <= cmax[nb]) ? __builtin_amdgcn_exp2f(S[mb][nb][j]) * invC[nb] : 0.f;
            const int jb = h * 16 + mb * 4 + quad;
            const int idx = (w * 32 + nb * 16 + c16) * 33 + jb;
            impM[idx] = S[mb][nb][0] + S[mb][nb][1] + S[mb][nb][2] + 0.5f * S[mb][nb][3];
            impT[idx] = 0.5f * S[mb][nb][3];
          }
        pv_tile(Vs, h * 64, S, Oc, c16, quad);
      }
#pragma unroll
      for (int nb = 0; nb < 2; ++nb) {
        const float gc = gates[(tok0 + nb * 16 + c16) * 48 + hq];
#pragma unroll
        for (int db = 0; db < 4; ++db) of[db][nb] += Oc[db][nb] * gc;
      }
      __syncthreads();
      {
        const int qq = tid & 31, jg = tid >> 5;
        const int cur = (s0 + qq) >> 6;
#pragma unroll
        for (int k = 0; k < 4; ++k) {
          const int j = jg * 4 + k;
          float imp = 0.f;
#pragma unroll
          for (int ww = 0; ww < 4; ++ww) {
            imp += impM[(ww * 32 + qq) * 33 + j];
            if (j > 0) imp += impT[(ww * 32 + qq) * 33 + j - 1];
          }
          float s = imp;
          if (j > cur) s = -1e30f; else if (j == 0 || cur - j < 2) s = 1e30f;
          sc[qq * 33 + j] = s;
        }
        __syncthreads();
        unsigned bits = 0u;
#pragma unroll
        for (int k = 0; k < 4; ++k) {
          const int j = jg * 4 + k;
          const float sj = sc[qq * 33 + j];
          int cnt = 0;
          for (int i = 0; i < 32; ++i) { const float si = sc[qq * 33 + i]; cnt += (si > sj || (si == sj && i < j)) ? 1 : 0; }
          if (cnt < 16) bits |= 1u << j;
        }
        atomicOr(&selm[qq], bits);
        atomicOr(anyj, bits);
      }
    }
    __syncthreads();
    unsigned sel[2]; sel[0] = selm[c16]; sel[1] = selm[16 + c16];
    const unsigned anym = *anyj;

    {
      f32x4 O2[4][2]; float m[2] = {-1e30f, -1e30f}, l[2] = {0.f, 0.f};
#pragma unroll
      for (int db = 0; db < 4; ++db)
#pragma unroll
        for (int nb = 0; nb < 2; ++nb) O2[db][nb] = f32x4{0.f, 0.f, 0.f, 0.f};
      const int jmax = (s0 + 31) >> 6;
      unsigned rem = anym & ((2u << jmax) - 1u);
      const int r0 = tid >> 3, c0 = tid & 7;
      const u16* kbase = ksl + (size_t)bg * SEQL * 64 + r0 * 64 + c0 * 8;
      const u16* vbase = vst + (size_t)bg * 64 * SEQL + (size_t)r0 * SEQL + c0 * 8;
      uint4 rk0, rk1, rv0, rv1;
      int j = __ffs(rem) - 1;
      rk0 = *(const uint4*)(kbase + (size_t)j * 64 * 64); rk1 = *(const uint4*)(kbase + (size_t)j * 64 * 64 + 32 * 64);
      rv0 = *(const uint4*)(vbase + j * 64); rv1 = *(const uint4*)(vbase + j * 64 + (size_t)32 * SEQL);
      for (;;) {
        rem &= rem - 1u;
        __syncthreads();
        *(uint4*)(Ks + r0 * 72 + c0 * 8) = rk0; *(uint4*)(Ks + (r0 + 32) * 72 + c0 * 8) = rk1;
        *(uint4*)(Vs + r0 * 136 + c0 * 8) = rv0; *(uint4*)(Vs + (r0 + 32) * 136 + c0 * 8) = rv1;
        __syncthreads();
        const int jn = rem ? (__ffs(rem) - 1) : -1;
        if (jn >= 0) {
          rk0 = *(const uint4*)(kbase + (size_t)jn * 64 * 64); rk1 = *(const uint4*)(kbase + (size_t)jn * 64 * 64 + 32 * 64);
          rv0 = *(const uint4*)(vbase + jn * 64); rv1 = *(const uint4*)(vbase + jn * 64 + (size_t)32 * SEQL);
        }
        int lim[2];
        lim[0] = ((sel[0] >> j) & 1u) ? (tq[0] - j * 64 - quad * 4) : -1;
        lim[1] = ((sel[1] >> j) & 1u) ? (tq[1] - j * 64 - quad * 4) : -1;
        auto valid = [&](int nb, int kk) -> bool { return kk <= lim[nb]; };
        const bool full = (j * 64 + 63 <= s0) && __all((int)(((sel[0] >> j) & (sel[1] >> j)) & 1u));
        if (full) flash_step<true>(Ks, Vs, qf, O2, m, l, valid, c16, quad);
        else flash_step<false>(Ks, Vs, qf, O2, m, l, valid, c16, quad);
        if (jn < 0) break;
        j = jn;
      }
#pragma unroll
      for (int nb = 0; nb < 2; ++nb) {
        const float gs = gates[(tok0 + nb * 16 + c16) * 48 + 16 + hq] * ((l[nb] > 0.f) ? 1.f / l[nb] : 0.f);
#pragma unroll
        for (int db = 0; db < 4; ++db) of[db][nb] += O2[db][nb] * gs;
      }
    }
    {
      f32x4 O3[4][2]; float m[2] = {-1e30f, -1e30f}, l[2] = {0.f, 0.f};
#pragma unroll
      for (int db = 0; db < 4; ++db)
#pragma unroll
        for (int nb = 0; nb < 2; ++nb) O3[db][nb] = f32x4{0.f, 0.f, 0.f, 0.f};
      const int jlo = (s0 >= 511) ? ((s0 - 511) >> 6) : 0, jhi = (s0 + 31) >> 6;
      const int r0 = tid >> 3, c0 = tid & 7;
      const u16* kbase = kwn + (size_t)bg * SEQL * 64 + r0 * 64 + c0 * 8;
      const u16* vbase = vwt + (size_t)bg * 64 * SEQL + (size_t)r0 * SEQL + c0 * 8;
      uint4 rk0, rk1, rv0, rv1;
      rk0 = *(const uint4*)(kbase + (size_t)jlo * 64 * 64); rk1 = *(const uint4*)(kbase + (size_t)jlo * 64 * 64 + 32 * 64);
      rv0 = *(const uint4*)(vbase + jlo * 64); rv1 = *(const uint4*)(vbase + jlo * 64 + (size_t)32 * SEQL);
      for (int j = jlo; j <= jhi; ++j) {
        __syncthreads();
        *(uint4*)(Ks + r0 * 72 + c0 * 8) = rk0; *(uint4*)(Ks + (r0 + 32) * 72 + c0 * 8) = rk1;
        *(uint4*)(Vs + r0 * 136 + c0 * 8) = rv0; *(uint4*)(Vs + (r0 + 32) * 136 + c0 * 8) = rv1;
        __syncthreads();
        if (j < jhi) {
          const int jn = j + 1;
          rk0 = *(const uint4*)(kbase + (size_t)jn * 64 * 64); rk1 = *(const uint4*)(kbase + (size_t)jn * 64 * 64 + 32 * 64);
          rv0 = *(const uint4*)(vbase + jn * 64); rv1 = *(const uint4*)(vbase + jn * 64 + (size_t)32 * SEQL);
        }
        int lim[2]; lim[0] = tq[0] - j * 64 - quad * 4; lim[1] = tq[1] - j * 64 - quad * 4;
        auto valid = [&](int nb, int kk) -> bool { return (kk <= lim[nb]) && (kk > lim[nb] - 512); };
        const bool full = (j * 64 + 63 <= s0) && (j * 64 > s0 + 31 - 512);
        if (full) flash_step<true>(Ks, Vs, qf, O3, m, l, valid, c16, quad);
        else flash_step<false>(Ks, Vs, qf, O3, m, l, valid, c16, quad);
      }
#pragma unroll
      for (int nb = 0; nb < 2; ++nb) {
        const float gs = gates[(tok0 + nb * 16 + c16) * 48 + 32 + hq] * ((l[nb] > 0.f) ? 1.f / l[nb] : 0.f);
#pragma unroll
        for (int db = 0; db < 4; ++db) of[db][nb] += O3[db][nb] * gs;
      }
    }
#pragma unroll
    for (int nb = 0; nb < 2; ++nb)
#pragma unroll
      for (int db = 0; db < 4; ++db) {
        uint2 pk; pk.x = pack2(of[db][nb][0], of[db][nb][1]); pk.y = pack2(of[db][nb][2], of[db][nb][3]);
        *(uint2*)(Oo + (tok0 + nb * 16 + c16) * 1024 + hq * 64 + db * 16 + quad * 4) = pk;
      }
  }
}

__device__ __forceinline__ bool dbg_bad(float got, float ref) { return !(fabsf(got - ref) <= 0.03f + 0.04f * fabsf(ref)); }
__device__ __forceinline__ void check_ain(const KArgs& a) {
  const int gt = blockIdx.x * NTHREADS + otid();
  if (gt >= 65536) return;
  const unsigned s = (unsigned)gt;
  const int row = (int)(s & 31u) * 2048, col = (int)(s >> 5);
  const int b = row >> 11, ch = col & 1023;
  const u16* u = (const u16*)(a.ws + OFF_U) + (size_t)row * 1024;
  const float* w = a.in[I_AWIN] + col;
  float acc = 0.f;
  for (int k = 0; k < 1024; ++k) acc += bf2f(u[k]) * w[(size_t)k * 2048];
  const u16* Y = (const u16*)(a.ws + OFF_BUFA);
  float got, ref;
  if (col < 1024) { got = bf2f(Y[(size_t)row * 1024 + col]); ref = gelu_tanh(acc); }
  else { got = bf2f(Y[(size_t)T_TOK * 1024 + (size_t)row * 1024 + col - 1024]); ref = acc; }
  if (dbg_bad(got, ref)) { atomicAdd((unsigned*)(a.ws + OFF_FLAG), 1u); ((unsigned*)(a.ws + OFF_FLAG))[16 + ch] = 1u; ((unsigned*)(a.ws + OFF_FLAG))[1100 + b] = 1u; }

}
__device__ __forceinline__ void check_scan(const KArgs& a) {
  const int gt = blockIdx.x * NTHREADS + otid();
  if (gt >= 32768) return;
  const unsigned s = (unsigned)gt;
  const int b = (int)(s & 31u), ch = (int)(s >> 5), hd = ch >> 7;
  const u16* Y = (const u16*)(a.ws + OFF_BUFA);
  const u16* ZR = Y + (size_t)T_TOK * 1024;
  const float* gw = (const float*)(a.ws + OFF_HID);
  const float lam = a.in[I_ALAM][ch];
  const float cl = -8.f * log1pf(expf(-lam));
  float h = 0.f;
  bool bad = false;
  for (int t = 0; t < 1; ++t) {
    float g0 = a.in[I_AGATEB][ch], g1 = a.in[I_AGATEB][1024 + ch], xme = 0.f;
    for (int i = 0; i < 128; ++i) {
      const int ci = hd * 128 + i;
      float xr = a.in[I_ACONVB][ci];
      for (int k = 0; k < 4; ++k) { const int tt = t - 3 + k; if (tt >= 0) xr += a.in[I_ACONVW][k * 1024 + ci] * bf2f(ZR[((size_t)b * SEQL + tt) * 1024 + ci]); }
      g0 += xr * gw[((size_t)(0 * 8 + hd) * 128 + i) * 128 + (ch & 127)];
      g1 += xr * gw[((size_t)(1 * 8 + hd) * 128 + i) * 128 + (ch & 127)];
      if (ci == ch) xme = xr;
    }
    const float r = 1.f / (1.f + expf(-g0)), ig = 1.f / (1.f + expf(-g1));
    const float la = cl * r, av = expf(la), bt = sqrtf(fmaxf(-expm1f(2.f * la), 0.f)) * ig * xme;
    h = av * h + bt;
    const u16* u = (const u16*)(a.ws + OFF_U) + ((size_t)b * SEQL + t) * 1024;
    float acc = 0.f;
    for (int k = 0; k < 1024; ++k) acc += bf2f(u[k]) * a.in[I_AWIN][(size_t)k * 2048 + ch];
    const float ref = gelu_tanh(acc) * h;
    const float got = bf2f(Y[((size_t)b * SEQL + t) * 1024 + ch]);
    if (t == 0 && dbg_bad(got, ref)) { atomicAdd((unsigned*)(a.ws + OFF_FLAG), 1u); ((unsigned*)(a.ws + OFF_FLAG))[16 + ch] = 1u; ((unsigned*)(a.ws + OFF_FLAG))[1100 + b] = 1u; }
  }
}
__device__ __forceinline__ void check_ffn1(const KArgs& a) {
  const int gt = blockIdx.x * NTHREADS + otid();
  if (gt >= 8192) return;
  const unsigned s = (unsigned)gt;
  const int row = (int)((s * 2654435761u) >> 16), hid = (int)((s * 40503u + 17u) % 2816u);
  const u16* u = (const u16*)(a.ws + OFF_U) + (size_t)row * 1024;
  const float* w = a.in[I_FWIN];
  float g = 0.f, up = 0.f;
  for (int k = 0; k < 1024; ++k) { const float uv = bf2f(u[k]); g += uv * w[(size_t)k * 5632 + hid]; up += uv * w[(size_t)k * 5632 + 2816 + hid]; }
  const float ref = g / (1.f + expf(-g)) * up;
  const float got = bf2f(((const u16*)(a.ws + OFF_BUFA))[(size_t)row * FHID + hid]);

}
__device__ __forceinline__ void check_ffn2(const KArgs& a, const float* hold) {
}

#define N_PHASES 37
#define BISECT_HI N_PHASES

__global__ void __launch_bounds__(NTHREADS, 2) yoco_mega(KArgs a) {
  extern __shared__ __attribute__((aligned(16))) char smem[];
  cg::grid_group grid = cg::this_grid();
  char* ws = a.ws;
  volatile LDS_AS unsigned* xbst = (volatile LDS_AS unsigned*)(smem + SMEM_BYTES - 16);
  if (threadIdx.x == 0) { xbst[0] = 0u; xbst[1] = 0u; }
  __syncthreads();
  const XcdBarrier xb = xcd_barrier_post((unsigned*)(ws + OFF_BAR), xbst);
  const float* rope = (const float*)(ws + OFF_ROPE);
  int ph = 0;
#define GRID_BARRIER() { asm volatile("s_waitcnt vmcnt(0)" ::: "memory"); __builtin_amdgcn_fence(__ATOMIC_RELEASE, "agent"); asm volatile("s_waitcnt vmcnt(0)" ::: "memory"); \
    grid.sync(); __builtin_amdgcn_fence(__ATOMIC_ACQUIRE, "agent"); asm volatile("s_waitcnt vmcnt(0)" ::: "memory"); }
#define PHASE(...) { if (ph >= a.lo && ph < a.hi) { __VA_ARGS__; if (ph + 1 < a.hi) { if (a.lo < 0) { GRID_BARRIER(); } else xcd_barrier(xb); } } ++ph; }
  PHASE(prep_phase(a, smem))
  for (int layer = 0; layer < 4; ++layer) {
    if (layer < 2) {
      const int L = layer;
      const float* hin = (L == 0) ? a.in[I_X] : a.out;
      PHASE(norm_phase(hin, a.in[I_ANORM] + (size_t)L * 1024, (u16*)(ws + OFF_U)))
      PHASE({
        APlain ap{(const u16*)(ws + OFF_U), 1024};
        EpAin ep{(u16*)(ws + OFF_BUFA), (u16*)(ws + OFF_BUFA) + (size_t)T_TOK * 1024};
        gemm_phase(ap, (const u16*)(ws + OFF_W_AIN) + (size_t)L * 2048 * 1024, 1024, 512, 16, ep, smem, 4);
      })
      PHASE(conv_phase(a, L))
      PHASE(gates_phase(a, L, smem))
      PHASE(scan_phase(a, smem))
      PHASE({
        APlain ap{(const u16*)(ws + OFF_U), 1024};
        EpRes ep{hin, a.out, ABL_A};
        gemm_phase(ap, (const u16*)(ws + OFF_W_AOUT) + (size_t)L * 1024 * 1024, 1024, 512, 8, ep, smem, 8);
      })
    } else {
      const int Lb = layer - 2;
      if (Lb == 0) {
        PHASE(norm_phase(a.out, a.in[I_KVNORM], (u16*)(ws + OFF_U)))
        PHASE({
          APlain ap{(const u16*)(ws + OFF_U), 1024};
          EpKV ep{ws, a.in[I_KNORM], rope};
          gemm_phase(ap, (const u16*)(ws + OFF_W_KV), 1024, 512, 12, ep, smem, 4);
        })
        PHASE({
          for (int kv = 0; kv < 2; ++kv) {
            ACmp ap{(const u16*)(ws + (kv == 0 ? OFF_KC : OFF_VC))};
            EpCmp1 ep{(u16*)(ws + OFF_HID) + (size_t)kv * 16256 * 256, (const float*)(ws + OFF_PB) + kv * 16 * 256, a.in[I_CMPB1] + kv * 256};
            gemm_phase(ap, (const u16*)(ws + OFF_W_C1) + (size_t)kv * 256 * 2048, 2048, 127, 2, ep, smem, 2);
          }
        })
        PHASE({
          for (int kv = 0; kv < 2; ++kv) {
            APlain ap{(const u16*)(ws + OFF_HID) + (size_t)kv * 16256 * 256, 256};
            EpCmp2 ep{ws, kv, a.in[I_CMPB2] + kv * 64, a.in[I_KNORM], rope};
            gemm_phase(ap, (const u16*)(ws + OFF_W_C2) + (size_t)kv * 128 * 256, 256, 127, 1, ep, smem, 1);
          }
        })
      }
      PHASE(norm_phase(a.out, a.in[I_BNORM] + (size_t)Lb * 1024, (u16*)(ws + OFF_U)))
      PHASE({
        APlain ap{(const u16*)(ws + OFF_U), 1024};
        EpQ ep{(u16*)(ws + OFF_BUFA), (float*)(ws + OFF_GATES), a.in[I_QNORM] + Lb * 64, a.in[I_BGATEB] + Lb * 48, rope};
        gemm_phase(ap, (const u16*)(ws + OFF_W_BIN) + (size_t)Lb * 1152 * 1024, 1024, 512, 9, ep, smem, 3);
      })
      PHASE(attn_phase(a, smem))
      PHASE({
        APlain ap{(const u16*)(ws + OFF_BUFA) + (size_t)T_TOK * 1024, 1024};
        EpRes ep{a.out, a.out, ABL_B};
        gemm_phase(ap, (const u16*)(ws + OFF_W_BOUT) + (size_t)Lb * 1024 * 1024, 1024, 512, 8, ep, smem, 8);
      })
    }
    PHASE(norm_phase(a.out, a.in[I_FNORM] + (size_t)layer * 1024, (u16*)(ws + OFF_U)))
    PHASE({
      APlain ap{(const u16*)(ws + OFF_U), 1024};
      EpFfn1 ep{(u16*)(ws + OFF_BUFA)};
      gemm_phase(ap, (const u16*)(ws + OFF_W_FIN) + (size_t)layer * 5632 * 1024, 1024, 512, 44, ep, smem, 4);
    })
    PHASE({
      APlain ap{(const u16*)(ws + OFF_BUFA), FHID};
      EpRes ep{a.out, a.out, ABL_F};
      gemm_phase(ap, (const u16*)(ws + OFF_W_FOUT) + (size_t)layer * 1024 * FHID, FHID, 512, 8, ep, smem, 8);
    })
  }
#undef PHASE
}

extern "C" void kernel_launch(void* const* d_in, const int* in_sizes, int n_in, void* d_out, int out_size, void* d_ws, size_t ws_size,
                              hipStream_t stream) {
  static int grid_blocks = 0;
  if (!grid_blocks) {
    int dev = 0, cus = 0, per_cu = 0;
    hipGetDevice(&dev);
    hipDeviceGetAttribute(&cus, hipDeviceAttributeMultiprocessorCount, dev);
    if (hipFuncSetAttribute((const void*)yoco_mega, hipFuncAttributeMaxDynamicSharedMemorySize, SMEM_BYTES) != hipSuccess) fprintf(stderr, "hipFuncSetAttribute failed\n");
    hipOccupancyMaxActiveBlocksPerMultiprocessor(&per_cu, (const void*)yoco_mega, NTHREADS, SMEM_BYTES);
    if (per_cu < 1) per_cu = 1;
    if (per_cu > 2) per_cu = 2;
    grid_blocks = cus * per_cu;
  }
  if (ws_size < WS_END) { fprintf(stderr, "ws too small: %zu < %zu\n", ws_size, (size_t)WS_END); return; }
  { static const int exp_sizes[25] = {65536*1024, 2*1024, 2*1024*2048, 2*4*1024, 2*1024, 2*2*8*128*128, 2*2*1024, 2*1024, 2*1024*1024, 1024, 1024*1536, 3*64, 2*32*64, 2*2048*256, 2*256, 2*256*64, 2*64, 2*1024, 2*1024*1072, 2*48, 2*64, 2*1024*1024, 4*1024, 4*1024*5632, 4*2816*1024};
    if (n_in != 25) return;
    for (int i = 0; i < 25; ++i) if (in_sizes[i] != exp_sizes[i]) { fprintf(stderr, "in_sizes[%d] = %d, expected %d\n", i, in_sizes[i], exp_sizes[i]); return; } }
  KArgs a{};
  for (int i = 0; i < 25; ++i) a.in[i] = (const float*)d_in[i];
  a.out = (float*)d_out;
  a.ws = (char*)d_ws;
  hipMemsetAsync((char*)d_ws + OFF_BAR, 0, XCD_BAR_BYTES, stream);
  hipMemcpyAsync((char*)d_ws + OFF_HID, d_in[5], (size_t)in_sizes[5] * 4, hipMemcpyDeviceToDevice, stream);
#ifdef MULTI_LAUNCH
  for (int ph = 0; ph < N_PHASES; ++ph) {
    a.lo = ph; a.hi = ph + 1;
    hipLaunchKernelGGL(yoco_mega, dim3(grid_blocks), dim3(NTHREADS), SMEM_BYTES, stream, a);
  }
#else
  a.lo = 0; a.hi = BISECT_HI;
  void* args[] = {&a};
  hipError_t e = hipLaunchCooperativeKernel((void*)yoco_mega, dim3(grid_blocks), dim3(NTHREADS), args, SMEM_BYTES, stream);
  if (e != hipSuccess) fprintf(stderr, "cooperative launch failed: %s (grid %d)\n", hipGetErrorString(e), grid_blocks);
#endif
}
```

```cpp
#include <hip/hip_runtime.h>
#include <hip/hip_cooperative_groups.h>
#include <cstdio>
#include <cstdint>
namespace cg = cooperative_groups;

typedef unsigned short u16;
typedef short bf16x8 __attribute__((ext_vector_type(8)));
typedef float f32x4 __attribute__((ext_vector_type(4)));
typedef unsigned u32x4 __attribute__((ext_vector_type(4)));

#define T_TOK 65536
#define SEQL 2048
#define FHID 2816
#define NTHREADS 256
#define XCD_BAR_BYTES 16384
#define SMEM_BYTES 74240
#ifndef ABL_A
#define ABL_A 1.f
#endif
#ifndef ABL_B
#define ABL_B 1.f
#endif
#ifndef ABL_F
#define ABL_F 1.f
#endif
#define PREP_TILES (1024 + 512 + 384 + 256 + 16 + 576 + 512 + 5632 + 2816)

constexpr size_t OFF_W_AIN  = 0;
constexpr size_t OFF_W_GATE = OFF_W_AIN  + (size_t)2 * 2048 * 1024 * 2;
constexpr size_t OFF_W_AOUT = OFF_W_GATE + (size_t)64 * 128 * 128 * 2;
constexpr size_t OFF_W_KV   = OFF_W_AOUT + (size_t)2 * 1024 * 1024 * 2;
constexpr size_t OFF_W_C1   = OFF_W_KV   + (size_t)1536 * 1024 * 2;
constexpr size_t OFF_W_C2   = OFF_W_C1   + (size_t)2 * 256 * 2048 * 2;
constexpr size_t OFF_W_BIN  = OFF_W_C2   + (size_t)2 * 128 * 256 * 2;
constexpr size_t OFF_W_BOUT = OFF_W_BIN  + (size_t)2 * 1152 * 1024 * 2;
constexpr size_t OFF_W_FIN  = OFF_W_BOUT + (size_t)2 * 1024 * 1024 * 2;
constexpr size_t OFF_W_FOUT = OFF_W_FIN  + (size_t)4 * 5632 * 1024 * 2;
constexpr size_t OFF_ROPE   = OFF_W_FOUT + (size_t)4 * 1024 * 2816 * 2;
constexpr size_t OFF_PB     = OFF_ROPE   + (size_t)2048 * 32 * 2 * 4;
constexpr size_t OFF_U      = OFF_PB     + (size_t)2 * 16 * 256 * 4;
constexpr size_t OFF_BUFA   = OFF_U      + (size_t)T_TOK * 1024 * 2;
constexpr size_t OFF_KC     = OFF_BUFA   + (size_t)T_TOK * FHID * 2;
constexpr size_t OFF_VC     = OFF_KC     + (size_t)T_TOK * 256 * 2;
constexpr size_t OFF_KS     = OFF_VC     + (size_t)T_TOK * 256 * 2;
constexpr size_t OFF_KW     = OFF_KS     + (size_t)T_TOK * 256 * 2;
constexpr size_t OFF_VST    = OFF_KW     + (size_t)T_TOK * 256 * 2;
constexpr size_t OFF_VWT    = OFF_VST    + (size_t)T_TOK * 256 * 2;
constexpr size_t OFF_KCMP   = OFF_VWT    + (size_t)T_TOK * 256 * 2;
constexpr size_t OFF_VCMPT  = OFF_KCMP   + (size_t)128 * 128 * 64 * 2;
constexpr size_t OFF_HID    = OFF_VCMPT  + (size_t)128 * 64 * 128 * 2;
constexpr size_t OFF_GATES  = OFF_HID    + (size_t)2 * 16256 * 256 * 2;
#define OFF_FLAG (OFF_GATES + (size_t)T_TOK * 48 * 4)
#define OFF_BAR (OFF_FLAG + 16384)
constexpr size_t WS_END     = OFF_GATES  + (size_t)T_TOK * 48 * 4 + 16384 + XCD_BAR_BYTES;

struct KArgs {
  const float* in[25];
  float* out;
  char* ws;
  int lo, hi;
};
enum { I_X = 0, I_ANORM, I_AWIN, I_ACONVW, I_ACONVB, I_AGATEW, I_AGATEB, I_ALAM, I_AWOUT, I_KVNORM, I_KVW, I_KNORM,
       I_CMPPOS, I_CMPW1, I_CMPB1, I_CMPW2, I_CMPB2, I_BNORM, I_BWIN, I_BGATEB, I_QNORM, I_BWOUT, I_FNORM, I_FWIN, I_FWOUT };

__device__ __forceinline__ unsigned pack2(float lo, float hi) { unsigned r; asm("v_cvt_pk_bf16_f32 %0, %1, %2" : "=v"(r) : "v"(lo), "v"(hi)); return r; }
__device__ __forceinline__ u16 f2bf(float f) { return (u16)pack2(f, f); }
__device__ __forceinline__ float bf2f(u16 h) { return __uint_as_float(((unsigned)h) << 16); }
__device__ __forceinline__ float sigmoidf_(float x) { return __builtin_amdgcn_rcpf(1.f + __expf(-x)); }
__device__ __forceinline__ float gelu_tanh(float x) { float u = 0.7978845608028654f * (x + 0.044715f * x * x * x); return x * __builtin_amdgcn_rcpf(1.f + __expf(-2.f * u)); }
__device__ __forceinline__ f32x4 mfma16(bf16x8 a, bf16x8 b, f32x4 c) { return __builtin_amdgcn_mfma_f32_16x16x32_bf16(a, b, c, 0, 0, 0); }

__device__ __forceinline__ int otid() { int t = threadIdx.x; asm volatile("" : "+v"(t)); return t; }

#define LDS_AS __attribute__((address_space(3)))
struct APlain {
  const u16* A; int lda;
  __device__ __forceinline__ const u16* rowptr(int row) const { return A + (size_t)row * lda; }
  __device__ __forceinline__ int kstride() const { return 64; }
};
struct ACmp {
  const u16* kc;
  __device__ __forceinline__ const u16* rowptr(int row) const {
    const int g = row & 3, bc = row >> 2, b = bc / 127, c = bc - b * 127;
    return kc + ((size_t)(b * SEQL + c * 16) * 256 + g * 64);
  }
  __device__ __forceinline__ int kstride() const { return 256; }
};

template <class AP, class EP>
__device__ __forceinline__ void gemm_tile(const AP& ap, const u16* __restrict__ Bt, int K, int m0, int n0, const EP& ep, char* smem) {
  const int tid = otid(), lane = tid & 63, w = tid >> 6, wm = w >> 1, wn = w & 1, c16 = lane & 15, quad = lane >> 4;
  const int nk = K >> 6;
  const int srow = lane >> 2;
  const int scol = (w & 1) * 32 + ((((lane & 3) * 16) ^ ((lane >> 5) << 5)) >> 1);
  const u16* ga[4]; const u16* gb[4];
#pragma unroll
  for (int p = 0; p < 4; ++p) {
    const int R = ((w >> 1) + 2 * p) * 16 + srow;
    ga[p] = ap.rowptr(m0 + R) + scol;
    gb[p] = Bt + (size_t)(n0 + R) * K + scol;
  }
  const int kstr = ap.kstride();
  const int lofs = (c16 * 64 + quad * 16) ^ ((c16 >> 3) << 5);
  f32x4 acc[4][4];
#pragma unroll
  for (int i = 0; i < 4; ++i)
#pragma unroll
    for (int j = 0; j < 4; ++j) acc[i][j] = f32x4{0.f, 0.f, 0.f, 0.f};

#define GSTAGE(buf_, kt_)                                                                                                        \
  _Pragma("unroll") for (int p = 0; p < 4; ++p) {                                                                                \
    __builtin_amdgcn_global_load_lds((const unsigned*)(ga[p] + (size_t)(kt_) * kstr),                                            \
                                     (LDS_AS unsigned*)(smem + (buf_) * 32768 + w * 1024 + p * 4096), 16, 0, 0);                 \
    __builtin_amdgcn_global_load_lds((const unsigned*)(gb[p] + (size_t)(kt_) * 64),                                              \
                                     (LDS_AS unsigned*)(smem + (buf_) * 32768 + 16384 + w * 1024 + p * 4096), 16, 0, 0);         \
  }
  GSTAGE(0, 0);
  asm volatile("s_waitcnt vmcnt(0)" ::: "memory");
  __syncthreads();
  for (int kt = 0; kt < nk; ++kt) {
    const int cur = kt & 1;
    if (kt + 1 < nk) { GSTAGE(cur ^ 1, kt + 1); }
    const char* pa = smem + cur * 32768 + (wm * 8) * 1024 + lofs;
    const char* pb = smem + cur * 32768 + 16384 + (wn * 8) * 1024 + lofs;
#pragma unroll
    for (int ks = 0; ks < 2; ++ks) {
      bf16x8 af[4], bfr[4];
#pragma unroll
      for (int i = 0; i < 4; ++i) { af[i] = *(const bf16x8*)(pa + (i * 2 + ks) * 1024); bfr[i] = *(const bf16x8*)(pb + (i * 2 + ks) * 1024); }
      __builtin_amdgcn_s_setprio(1);
#pragma unroll
      for (int i = 0; i < 4; ++i)
#pragma unroll
        for (int j = 0; j < 4; ++j) acc[i][j] = EP::TR ? mfma16(bfr[j], af[i], acc[i][j]) : mfma16(af[i], bfr[j], acc[i][j]);
      __builtin_amdgcn_s_setprio(0);
    }
    __builtin_amdgcn_sched_barrier(0);
    asm volatile("s_waitcnt vmcnt(0)" ::: "memory");
    __syncthreads();
  }
#undef GSTAGE
  ep(acc, m0 + wm * 64, n0 + wn * 64, lane);
}

__device__ __forceinline__ bool super_tile(int it, int mtiles, int ntiles, int SN, int& m, int& n) {
  const int nbx = gridDim.x >> 3, x = blockIdx.x & 7, lb = blockIdx.x >> 3;
  const int SM = nbx / SN, scols = (ntiles + SN - 1) / SN;
  const int s = x + 8 * it, sr = s / scols, sc = s - sr * scols;
  m = sr * SM + (lb % SM); n = sc * SN + (lb / SM);
  return (lb < SM * SN) && (m < mtiles) && (n < ntiles);
}
__device__ __forceinline__ int super_iters(int mtiles, int ntiles, int SN) {
  const int nbx = gridDim.x >> 3, SM = nbx / SN;
  const int nsuper = ((ntiles + SN - 1) / SN) * ((mtiles + SM - 1) / SM);
  return (nsuper + 7) >> 3;
}
template <class AP, class EP>
__device__ __forceinline__ void gemm_phase(const AP& ap, const u16* Bt, int K, int mtiles, int ntiles, const EP& ep, char* smem, int SN) {
  const int iters = super_iters(mtiles, ntiles, SN);
  for (int it = 0; it < iters; ++it) {
    int m, n;
    if (super_tile(it, mtiles, ntiles, SN, m, n)) gemm_tile(ap, Bt, K, m * 128, n * 128, ep, smem);
  }
}


__device__ __forceinline__ void head_norm_rope(float (&v)[4], const float* __restrict__ gain, const float* __restrict__ rope, int pos, int c16, float outscale) {
  float ss = v[0] * v[0] + v[1] * v[1] + v[2] * v[2] + v[3] * v[3];
  ss += __shfl_xor(ss, 1); ss += __shfl_xor(ss, 2); ss += __shfl_xor(ss, 4); ss += __shfl_xor(ss, 8);
  const float rs = rsqrtf(ss * (1.f / 64.f) + 1e-6f) * outscale;
  const float y0 = v[0] * rs * gain[c16], y1 = v[1] * rs * gain[16 + c16], y2 = v[2] * rs * gain[32 + c16], y3 = v[3] * rs * gain[48 + c16];
  const float2 cs0 = *(const float2*)(rope + ((size_t)pos * 32 + c16) * 2);
  const float2 cs1 = *(const float2*)(rope + ((size_t)pos * 32 + 16 + c16) * 2);
  v[0] = y0 * cs0.x - y2 * cs0.y; v[2] = y0 * cs0.y + y2 * cs0.x;
  v[1] = y1 * cs1.x - y3 * cs1.y; v[3] = y1 * cs1.y + y3 * cs1.x;
}

struct EpAin {
  static constexpr bool TR = true;
  u16* y; u16* zr;
  __device__ __forceinline__ void operator()(f32x4 (&acc)[4][4], int mb, int nb, int lane) const {
    const int c16 = lane & 15, quad = lane >> 4;
#pragma unroll
    for (int mi = 0; mi < 4; ++mi)
#pragma unroll
      for (int ni = 0; ni < 4; ++ni) {
        const int row = mb + mi * 16 + c16, col = nb + ni * 16 + quad * 4;
        uint2 pk;
        if (nb < 1024) {
          pk.x = pack2(gelu_tanh(acc[mi][ni][0]), gelu_tanh(acc[mi][ni][1])); pk.y = pack2(gelu_tanh(acc[mi][ni][2]), gelu_tanh(acc[mi][ni][3]));
          *(uint2*)(y + (size_t)row * 1024 + col) = pk;
        } else {
          pk.x = pack2(acc[mi][ni][0], acc[mi][ni][1]); pk.y = pack2(acc[mi][ni][2], acc[mi][ni][3]);
          *(uint2*)(zr + (size_t)row * 1024 + col - 1024) = pk;
        }
      }
  }
};
struct EpRes {
  static constexpr bool TR = true;
  const float* res; float* out; float sc;
  __device__ __forceinline__ void operator()(f32x4 (&acc)[4][4], int mb, int nb, int lane) const {
    const int c16 = lane & 15, quad = lane >> 4;
#pragma unroll
    for (int mi = 0; mi < 4; ++mi)
#pragma unroll
      for (int ni = 0; ni < 4; ++ni) {
        const size_t idx = (size_t)(mb + mi * 16 + c16) * 1024 + nb + ni * 16 + quad * 4;
        const float4 r = *(const float4*)(res + idx);
        float4 o; o.x = r.x + sc * acc[mi][ni][0]; o.y = r.y + sc * acc[mi][ni][1]; o.z = r.z + sc * acc[mi][ni][2]; o.w = r.w + sc * acc[mi][ni][3];
        *(float4*)(out + idx) = o;
      }
  }
};
struct EpFfn1 {
  static constexpr bool TR = true;
  u16* act;
  __device__ __forceinline__ void operator()(f32x4 (&acc)[4][4], int mb, int nb, int lane) const {
    const int c16 = lane & 15, quad = lane >> 4;
    const int hb = (nb >> 6) * 32;
#pragma unroll
    for (int mi = 0; mi < 4; ++mi)
#pragma unroll
      for (int ni = 0; ni < 2; ++ni) {
        float v[4];
#pragma unroll
        for (int jj = 0; jj < 4; ++jj) { const float g = acc[mi][ni][jj], u = acc[mi][ni + 2][jj]; v[jj] = g * u * __builtin_amdgcn_rcpf(1.f + __expf(-g)); }
        uint2 pk; pk.x = pack2(v[0], v[1]); pk.y = pack2(v[2], v[3]);
        *(uint2*)(act + (size_t)(mb + mi * 16 + c16) * FHID + hb + ni * 16 + quad * 4) = pk;
      }
  }
};
struct EpKV {
  static constexpr bool TR = false;
  char* ws; const float* knorm; const float* rope;
  __device__ __forceinline__ void operator()(f32x4 (&acc)[4][4], int mb, int nb, int lane) const {
    const int c16 = lane & 15, quad = lane >> 4;
    const int j6 = nb >> 8, g = (nb & 255) >> 6;
    const int b = mb / SEQL, sb = mb - b * SEQL;
    if (j6 < 2) {
      u16* dst = (u16*)(ws + (j6 == 0 ? OFF_KC : OFF_VC));
#pragma unroll
      for (int mi = 0; mi < 4; ++mi)
#pragma unroll
        for (int ni = 0; ni < 4; ++ni)
#pragma unroll
          for (int j = 0; j < 4; ++j)
            dst[(size_t)(mb + mi * 16 + quad * 4 + j) * 256 + g * 64 + ni * 16 + c16] = f2bf(acc[mi][ni][j]);
    } else if (j6 == 2 || j6 == 4) {
      u16* dst = (u16*)(ws + (j6 == 2 ? OFF_KS : OFF_KW));
      const float* gain = knorm + (j6 == 2 ? 64 : 128);
#pragma unroll
      for (int mi = 0; mi < 4; ++mi)
#pragma unroll
        for (int j = 0; j < 4; ++j) {
          const int s = sb + mi * 16 + quad * 4 + j;
          float v[4] = {acc[mi][0][j], acc[mi][1][j], acc[mi][2][j], acc[mi][3][j]};
          head_norm_rope(v, gain, rope, s, c16, 1.f);
#pragma unroll
          for (int ni = 0; ni < 4; ++ni) dst[((size_t)(b * 4 + g) * SEQL + s) * 64 + ni * 16 + c16] = f2bf(v[ni]);
        }
    } else {
      u16* dst = (u16*)(ws + (j6 == 3 ? OFF_VST : OFF_VWT));
#pragma unroll
      for (int mi = 0; mi < 4; ++mi)
#pragma unroll
        for (int ni = 0; ni < 4; ++ni) {
          const int d = ni * 16 + c16, s = sb + mi * 16 + quad * 4;
          uint2 pk; pk.x = pack2(acc[mi][ni][0], acc[mi][ni][1]); pk.y = pack2(acc[mi][ni][2], acc[mi][ni][3]);
          *(uint2*)(dst + ((size_t)(b * 4 + g) * 64 + d) * SEQL + s) = pk;
        }
    }
  }
};
struct EpCmp1 {
  static constexpr bool TR = false;
  u16* hid; const float* pbpart; const float* b1;
  __device__ __forceinline__ void operator()(f32x4 (&acc)[4][4], int mb, int nb, int lane) const {
    const int c16 = lane & 15, quad = lane >> 4;
#pragma unroll
    for (int ni = 0; ni < 4; ++ni) {
      const int col = nb + ni * 16 + c16;
      float pb = b1[col];
      for (int s = 0; s < 16; ++s) pb += pbpart[s * 256 + col];
#pragma unroll
      for (int mi = 0; mi < 4; ++mi)
#pragma unroll
        for (int j = 0; j < 4; ++j)
          hid[(size_t)(mb + mi * 16 + quad * 4 + j) * 256 + col] = f2bf(gelu_tanh(acc[mi][ni][j] + pb));
    }
  }
};
struct EpCmp2 {
  static constexpr bool TR = false;
  char* ws; int kv; const float* b2; const float* knorm; const float* rope;
  __device__ __forceinline__ void operator()(f32x4 (&acc)[4][4], int mb, int nb, int lane) const {
    if (nb & 64) return;
    const int c16 = lane & 15, quad = lane >> 4;
    float bb[4];
#pragma unroll
    for (int ni = 0; ni < 4; ++ni) bb[ni] = b2[ni * 16 + c16];
#pragma unroll
    for (int mi = 0; mi < 4; ++mi)
#pragma unroll
      for (int j = 0; j < 4; ++j) {
        const int row = mb + mi * 16 + quad * 4 + j;
        const int g = row & 3, bc = row >> 2, b = bc / 127, c = bc - b * 127;
        float v[4] = {acc[mi][0][j] + bb[0], acc[mi][1][j] + bb[1], acc[mi][2][j] + bb[2], acc[mi][3][j] + bb[3]};
        if (kv == 0) {
          head_norm_rope(v, knorm, rope, c * 16 + 31, c16, 1.f);
          u16* dst = (u16*)(ws + OFF_KCMP) + ((size_t)(b * 4 + g) * 128 + c) * 64;
#pragma unroll
          for (int ni = 0; ni < 4; ++ni) dst[ni * 16 + c16] = f2bf(v[ni]);
        } else {
          u16* dst = (u16*)(ws + OFF_VCMPT) + (size_t)(b * 4 + g) * 64 * 128 + c;
#pragma unroll
          for (int ni = 0; ni < 4; ++ni) dst[(size_t)(ni * 16 + c16) * 128] = f2bf(v[ni]);
        }
      }
  }
};
__device__ __forceinline__ void head_norm_rope_t(float (&v)[4][4], const float* __restrict__ gain, const float* __restrict__ rope, int pos, int quad, float outscale) {
  float ss = 0.f;
#pragma unroll
  for (int ni = 0; ni < 4; ++ni)
#pragma unroll
    for (int jj = 0; jj < 4; ++jj) ss += v[ni][jj] * v[ni][jj];
  ss += __shfl_xor(ss, 16); ss += __shfl_xor(ss, 32);
  const float rs = rsqrtf(ss * (1.f / 64.f) + 1e-6f) * outscale;
#pragma unroll
  for (int ni = 0; ni < 2; ++ni) {
    const int d = ni * 16 + quad * 4;
    const float4 g1 = *(const float4*)(gain + d), g2 = *(const float4*)(gain + d + 32);
    const float4 csa = *(const float4*)(rope + ((size_t)pos * 32 + d) * 2), csb = *(const float4*)(rope + ((size_t)pos * 32 + d) * 2 + 4);
    const float g1a[4] = {g1.x, g1.y, g1.z, g1.w}, g2a[4] = {g2.x, g2.y, g2.z, g2.w};
    const float cc[4] = {csa.x, csa.z, csb.x, csb.z}, sn[4] = {csa.y, csa.w, csb.y, csb.w};
#pragma unroll
    for (int jj = 0; jj < 4; ++jj) {
      const float y1 = v[ni][jj] * rs * g1a[jj], y2 = v[ni + 2][jj] * rs * g2a[jj];
      v[ni][jj] = y1 * cc[jj] - y2 * sn[jj];
      v[ni + 2][jj] = y1 * sn[jj] + y2 * cc[jj];
    }
  }
}
struct EpQ {
  static constexpr bool TR = true;
  u16* q; float* gates; const float* qnorm; const float* gate_b; const float* rope;
  __device__ __forceinline__ void operator()(f32x4 (&acc)[4][4], int mb, int nb, int lane) const {
    const int c16 = lane & 15, quad = lane >> 4;
    if (nb < 1024) {
      const float osc = 0.125f * 1.4426950408889634f;
#pragma unroll
      for (int mi = 0; mi < 4; ++mi) {
        const int row = mb + mi * 16 + c16;
        float v[4][4];
#pragma unroll
        for (int ni = 0; ni < 4; ++ni)
#pragma unroll
          for (int jj = 0; jj < 4; ++jj) v[ni][jj] = acc[mi][ni][jj];
        head_norm_rope_t(v, qnorm, rope, row & (SEQL - 1), quad, osc);
#pragma unroll
        for (int ni = 0; ni < 4; ++ni) {
          uint2 pk; pk.x = pack2(v[ni][0], v[ni][1]); pk.y = pack2(v[ni][2], v[ni][3]);
          *(uint2*)(q + (size_t)row * 1024 + nb + ni * 16 + quad * 4) = pk;
        }
      }
    } else if (nb == 1024) {
#pragma unroll
      for (int ni = 0; ni < 3; ++ni) {
        const int gi = ni * 16 + quad * 4;
        const float4 gb = *(const float4*)(gate_b + gi);
#pragma unroll
        for (int mi = 0; mi < 4; ++mi) {
          float4 o;
          o.x = sigmoidf_(acc[mi][ni][0] + gb.x); o.y = sigmoidf_(acc[mi][ni][1] + gb.y);
          o.z = sigmoidf_(acc[mi][ni][2] + gb.z); o.w = sigmoidf_(acc[mi][ni][3] + gb.w);
          *(float4*)(gates + (size_t)(mb + mi * 16 + c16) * 48 + gi) = o;
        }
      }
    }
  }
};

#define XB_TMO      128
#define XB_XCNT(j)  (256  + 64 * (j))
#define XB_XSUB(j)  (1280 + 64 * (j))
#define XB_XGEN(j)  (2304 + 64 * (j))
#define XB_TOP      3328
#define XB_TOPGEN   3392
#define XCD_BAR_WORDS 3456
#define XB_SPIN_CAP (1u << 22)
__device__ __forceinline__ unsigned xb_ld(unsigned* p)              { return __hip_atomic_load(p, __ATOMIC_RELAXED, __HIP_MEMORY_SCOPE_AGENT); }
__device__ __forceinline__ unsigned xb_add(unsigned* p, unsigned v) { return __hip_atomic_fetch_add(p, v, __ATOMIC_RELAXED, __HIP_MEMORY_SCOPE_AGENT); }
__device__ __forceinline__ unsigned xb_xcc_id() { return (unsigned)__builtin_amdgcn_s_getreg((3 << 11) | 20) & 0xFu; }
#define XB_SPIN(cond, bar) do { unsigned _sp = 0; while (cond) { __builtin_amdgcn_s_sleep(1); \
    if ((++_sp & 255u) == 0u) { if (xb_ld(&(bar)[XB_TMO])) break; if (_sp > XB_SPIN_CAP) { atomicAdd(&(bar)[XB_TMO], 1u); break; } } } } while (0)
struct XcdBarrier { unsigned* bar; unsigned x; volatile LDS_AS unsigned* st; };
__device__ __forceinline__ XcdBarrier xcd_barrier_post(unsigned* bar, volatile LDS_AS unsigned* st) {
  XcdBarrier b; b.bar = bar; b.x = xb_xcc_id(); b.st = st;
  if (threadIdx.x == 0) (void)xb_add(&bar[XB_XCNT(b.x)], 1u);
  return b;
}
__device__ __forceinline__ void xcd_barrier_complete(unsigned* bar, unsigned x, unsigned& nloc, unsigned& nx) {
  const unsigned G = gridDim.x * gridDim.y * gridDim.z;
  unsigned sum, cnt, mine, sp = 0u;
  for (;;) {
    sum = 0u; cnt = 0u; mine = 0u;
#pragma unroll
    for (unsigned j = 0; j < 16; ++j) { const unsigned c = xb_ld(&bar[XB_XCNT(j)]); sum += c; cnt += (c > 0u) ? 1u : 0u; mine = (j == x) ? c : mine; }
    if (sum == G) break;
    __builtin_amdgcn_s_sleep(1);
    if ((++sp & 255u) == 0u) { if (xb_ld(&bar[XB_TMO])) break; if (sp > XB_SPIN_CAP) { atomicAdd(&bar[XB_TMO], 1u); break; } }
  }
  nloc = mine > 0u ? mine : 1u; nx = cnt > 0u ? cnt : 1u;
}
__device__ __forceinline__ void xcd_barrier(const XcdBarrier& b) {
  asm volatile("s_waitcnt vmcnt(0)" ::: "memory");
  __syncthreads();
  if (threadIdx.x == 0) {
    unsigned* bar = b.bar;
    __builtin_amdgcn_s_waitcnt(0);
    unsigned nloc = b.st[0], nx = b.st[1];
    if (nloc == 0u) { xcd_barrier_complete(bar, b.x, nloc, nx); b.st[0] = nloc; b.st[1] = nx; }
    const unsigned old = xb_add(&bar[XB_XSUB(b.x)], 1u);
    const unsigned gen = old / nloc;
    if (old + 1u == (gen + 1u) * nloc) {
      __builtin_amdgcn_fence(__ATOMIC_RELEASE, "agent");
      asm volatile("s_waitcnt vmcnt(0)" ::: "memory");
      const unsigned og = xb_add(&bar[XB_TOP], 1u);
      const unsigned tg = og / nx;
      if (og + 1u == (tg + 1u) * nx) xb_add(&bar[XB_TOPGEN], 1u);
      else XB_SPIN(xb_ld(&bar[XB_TOPGEN]) == tg, bar);
      __builtin_amdgcn_fence(__ATOMIC_ACQUIRE, "agent");
      xb_add(&bar[XB_XGEN(b.x)], 1u);
      asm volatile("s_waitcnt vmcnt(0)" ::: "memory");
    } else {
      XB_SPIN(xb_ld(&bar[XB_XGEN(b.x)]) == gen, bar);
      __builtin_amdgcn_fence(__ATOMIC_ACQUIRE, "agent");
      asm volatile("s_waitcnt vmcnt(0)" ::: "memory");
    }
  }
  __syncthreads();
}

__device__ __forceinline__ void norm_phase(const float* __restrict__ h, const float* __restrict__ g, u16* __restrict__ u) {
  const int tidn = otid();
  const int lane = tidn & 63;
  const int gw = blockIdx.x * 4 + (tidn >> 6), nw = gridDim.x * 4;
  float4 gv[4];
#pragma unroll
  for (int i = 0; i < 4; ++i) gv[i] = *(const float4*)(g + i * 256 + lane * 4);
  for (int row = gw; row < T_TOK; row += nw) {
    const float* hr = h + (size_t)row * 1024;
    float4 v[4];
    float ss = 0.f;
#pragma unroll
    for (int i = 0; i < 4; ++i) { v[i] = *(const float4*)(hr + i * 256 + lane * 4); ss += v[i].x * v[i].x + v[i].y * v[i].y + v[i].z * v[i].z + v[i].w * v[i].w; }
#pragma unroll
    for (int o = 32; o >= 1; o >>= 1) ss += __shfl_xor(ss, o);
    const float rs = rsqrtf(ss * (1.f / 1024.f) + 1e-6f);
#pragma unroll
    for (int i = 0; i < 4; ++i) {
      uint2 pk; pk.x = pack2(v[i].x * rs * gv[i].x, v[i].y * rs * gv[i].y); pk.y = pack2(v[i].z * rs * gv[i].z, v[i].w * rs * gv[i].w);
      *(uint2*)(u + (size_t)row * 1024 + i * 256 + lane * 4) = pk;
    }
  }
}

__device__ __forceinline__ void do_transpose(const float* __restrict__ src, u16* __restrict__ dst, int K, int N, int Nd, int mode, int t, char* smem) {
  float* tile = (float*)smem;
  const int tid = otid();
  const int ktn = K >> 6, tpb = ktn * (Nd >> 6);
  const int bi = t / tpb, r = t - bi * tpb, nt = r / ktn, kt = r - nt * ktn;
  const float* sb = src + (size_t)bi * K * N;
  u16* db = dst + (size_t)bi * Nd * K;
  __syncthreads();
#pragma unroll 4
  for (int i = 0; i < 16; ++i) {
    const int e = tid + i * 256, kk = e >> 6, nn = e & 63;
    const int n1 = nt * 64 + nn;
    int sc = n1;
    if (mode == 1) { const int blk = n1 >> 6, rr = n1 & 63; const int hid = blk * 32 + (rr & 31); sc = (rr < 32) ? hid : (FHID + hid); }
    tile[kk * 65 + nn] = (sc < N) ? sb[(size_t)(kt * 64 + kk) * N + sc] : 0.f;
  }
  __syncthreads();
#pragma unroll 4
  for (int i = 0; i < 16; ++i) {
    const int e = tid + i * 256, nn = e >> 6, kk = e & 63;
    db[(size_t)(nt * 64 + nn) * K + kt * 64 + kk] = f2bf(tile[kk * 65 + nn]);
  }
}

__device__ __forceinline__ void prep_phase(const KArgs& a, char* smem) {
  char* ws = a.ws;
  constexpr int TOTAL = PREP_TILES;
  for (int tile = blockIdx.x; tile < TOTAL; tile += gridDim.x) {
    int t = tile;
#define JOB(S, D, K_, N_, ND_, B_, M_)                                                               \
    { constexpr int cnt = (B_) * ((K_) / 64) * ((ND_) / 64);                                         \
      if (t >= 0 && t < cnt) do_transpose((S), (u16*)(ws + (D)), (K_), (N_), (ND_), (M_), t, smem);  \
      t -= cnt; }
    JOB(a.in[I_AWIN],   OFF_W_AIN,  1024, 2048, 2048, 2, 0)
    JOB(a.in[I_AWOUT],  OFF_W_AOUT, 1024, 1024, 1024, 2, 0)
    JOB(a.in[I_KVW],    OFF_W_KV,   1024, 1536, 1536, 1, 0)
    JOB(a.in[I_CMPW1],  OFF_W_C1,   2048, 256,  256,  2, 0)
    JOB(a.in[I_CMPW2],  OFF_W_C2,   256,  64,   128,  2, 0)
    JOB(a.in[I_BWIN],   OFF_W_BIN,  1024, 1072, 1152, 2, 0)
    JOB(a.in[I_BWOUT],  OFF_W_BOUT, 1024, 1024, 1024, 2, 0)
    JOB(a.in[I_FWIN],   OFF_W_FIN,  1024, 5632, 5632, 4, 1)
    JOB(a.in[I_FWOUT],  OFF_W_FOUT, 2816, 1024, 1024, 4, 0)
#undef JOB
  }
  const int tidp = otid();
  const int gt = blockIdx.x * NTHREADS + tidp, ng = gridDim.x * NTHREADS;
  for (int i = gt; i < 2048; i += ng) ((float*)(ws + OFF_FLAG))[i] = -8.f * log1pf(expf(-a.in[I_ALAM][i]));
  {
    const float* gsrc = (const float*)(ws + OFF_HID);
    u16* gdst = (u16*)(ws + OFF_W_GATE);
    for (int i = gt; i < 2 * 2048 * 128; i += ng) {
      const int Lg = i >> 18, n = (i >> 7) & 2047, k = i & 127;
      const int hd = n >> 8, rp = n & 255, half = rp >> 7, q = (rp & 127) >> 6, rr = rp & 63, gate = rr >> 5;
      const int chl = half * 64 + q * 32 + (rr & 31);
      gdst[i] = f2bf(gsrc[((size_t)((Lg * 2 + gate) * 8 + hd) * 128 + k) * 128 + chl]);
    }
  }
  float* rope = (float*)(ws + OFF_ROPE);
  for (int i = gt; i < 2048 * 32; i += ng) {
    const int pos = i >> 5, fi = i & 31;
    const double freq = exp2(-(double)fi * (13.287712379549449 / 32.0));
    const double ang = (double)pos * freq;
    const double n = rint(ang * 0.15915494309189535);
    const float r = (float)(ang - n * 6.283185307179586);
    rope[2 * i] = cosf(r); rope[2 * i + 1] = sinf(r);
  }
  float* pb = (float*)(ws + OFF_PB);
  for (int it = blockIdx.x; it < 32; it += gridDim.x) {
    const int kv = it >> 4, ks = it & 15, n = tidp;
    const float* pos = a.in[I_CMPPOS] + kv * 2048 + ks * 128;
    const float* w1 = a.in[I_CMPW1] + ((size_t)kv * 2048 + ks * 128) * 256 + n;
    float s = 0.f;
    for (int k = 0; k < 128; ++k) s += pos[k] * w1[(size_t)k * 256];
    pb[(kv * 16 + ks) * 256 + n] = s;
  }
  u16* kcmp = (u16*)(ws + OFF_KCMP); u16* vcmpt = (u16*)(ws + OFF_VCMPT);
  for (int i = gt; i < 128 * 64; i += ng) {
    const int bg = i >> 6, d = i & 63;
    kcmp[((size_t)bg * 128 + 127) * 64 + d] = 0;
    vcmpt[((size_t)bg * 64 + d) * 128 + 127] = 0;
  }
}

__device__ __forceinline__ void conv_phase(const KArgs& a, int L) {
  const u16* ZR = (const u16*)(a.ws + OFF_BUFA) + (size_t)T_TOK * 1024;
  u16* XR = (u16*)(a.ws + OFF_U);
  const int gt = blockIdx.x * NTHREADS + otid(), ng = gridDim.x * NTHREADS;
  const int ch0 = (gt & 127) * 8;
  float cw[4][8], cb[8];
#pragma unroll
  for (int c = 0; c < 8; ++c) {
    cb[c] = a.in[I_ACONVB][(size_t)L * 1024 + ch0 + c];
#pragma unroll
    for (int k = 0; k < 4; ++k) cw[k][c] = a.in[I_ACONVW][(size_t)(L * 4 + k) * 1024 + ch0 + c];
  }
  for (int unit = gt; unit < (T_TOK / 16) * 128; unit += ng) {
    const int t0 = (unit >> 7) * 16, s0 = t0 & (SEQL - 1);
    const u16* src = ZR + (size_t)t0 * 1024 + ch0;
    uint4 rows[19];
#pragma unroll
    for (int r = 0; r < 19; ++r) {
      if (s0 + r - 3 >= 0) rows[r] = *(const uint4*)(src + (ptrdiff_t)(r - 3) * 1024);
      else rows[r] = make_uint4(0u, 0u, 0u, 0u);
    }
#pragma unroll
    for (int i = 0; i < 16; ++i) {
      float o[8];
#pragma unroll
      for (int c = 0; c < 8; ++c) o[c] = cb[c];
#pragma unroll
      for (int k = 0; k < 4; ++k) {
        const uint4 v = rows[i + k];
        const unsigned wv[4] = {v.x, v.y, v.z, v.w};
#pragma unroll
        for (int c = 0; c < 4; ++c) {
          o[2 * c] += cw[k][2 * c] * __uint_as_float(wv[c] << 16);
          o[2 * c + 1] += cw[k][2 * c + 1] * __uint_as_float(wv[c] & 0xffff0000u);
        }
      }
      uint4 pk; pk.x = pack2(o[0], o[1]); pk.y = pack2(o[2], o[3]); pk.z = pack2(o[4], o[5]); pk.w = pack2(o[6], o[7]);
      *(uint4*)(XR + (size_t)(t0 + i) * 1024 + ch0) = pk;
    }
  }
}

struct EpGate {
  static constexpr bool TR = true;
  const u16* xr; u16* la; u16* bv; const float* gb; const float* cl;
  __device__ __forceinline__ void operator()(f32x4 (&acc)[4][4], int mb, int nb, int lane) const {
    const int c16 = lane & 15, quad = lane >> 4;
    const int chb = (nb >> 8) * 128 + ((nb >> 7) & 1) * 64 + ((nb >> 6) & 1) * 32;
#pragma unroll
    for (int ni = 0; ni < 2; ++ni) {
      const int ch = chb + ni * 16 + quad * 4;
      const float4 g0 = *(const float4*)(gb + ch), g1 = *(const float4*)(gb + 1024 + ch), c4 = *(const float4*)(cl + ch);
      const float g0a[4] = {g0.x, g0.y, g0.z, g0.w}, g1a[4] = {g1.x, g1.y, g1.z, g1.w}, ca[4] = {c4.x, c4.y, c4.z, c4.w};
#pragma unroll
      for (int mi = 0; mi < 4; ++mi) {
        const size_t idx = (size_t)(mb + mi * 16 + c16) * 1024 + ch;
        const uint2 xv = *(const uint2*)(xr + idx);
        const float xa[4] = {__uint_as_float(xv.x << 16), __uint_as_float(xv.x & 0xffff0000u), __uint_as_float(xv.y << 16), __uint_as_float(xv.y & 0xffff0000u)};
        float lv[4], bt[4];
#pragma unroll
        for (int jj = 0; jj < 4; ++jj) {
          const float r = sigmoidf_(acc[mi][ni][jj] + g0a[jj]);
          const float ig = sigmoidf_(acc[mi][ni + 2][jj] + g1a[jj]);
          lv[jj] = ca[jj] * r;
          const float av = __expf(lv[jj]);
          bt[jj] = sqrtf(fmaxf(1.f - av * av, 0.f)) * (ig * xa[jj]);
        }
        uint2 pl; pl.x = pack2(lv[0], lv[1]); pl.y = pack2(lv[2], lv[3]);
        uint2 pb; pb.x = pack2(bt[0], bt[1]); pb.y = pack2(bt[2], bt[3]);
        *(uint2*)(la + idx) = pl; *(uint2*)(bv + idx) = pb;
      }
    }
  }
};

__device__ __forceinline__ void gates_phase(const KArgs& a, int L, char* smem) {
  char* ws = a.ws;
  const u16* XR = (const u16*)(ws + OFF_U);
  EpGate ep{XR, (u16*)(ws + OFF_BUFA) + (size_t)T_TOK * 1024, (u16*)(ws + OFF_KC), a.in[I_AGATEB] + (size_t)L * 2048, (const float*)(ws + OFF_FLAG) + (size_t)L * 1024};
  const u16* Bt = (const u16*)(ws + OFF_W_GATE) + (size_t)L * 2048 * 128;
  const int iters = super_iters(512, 16, 4);
  for (int it = 0; it < iters; ++it) {
    int m, n;
    if (super_tile(it, 512, 16, 4, m, n)) {
      APlain ap{XR + (n >> 1) * 128, 1024};
      gemm_tile(ap, Bt, 128, m * 128, n * 128, ep, smem);
    }
  }
}

__device__ __forceinline__ void scan_phase(const KArgs& a, char* smem) {
  float* sP = (float*)smem; float* sH = sP + 256;
  const int tid = otid(), lane = tid & 63, w = tid >> 6;
  const u16* Y = (const u16*)(a.ws + OFF_BUFA);
  const u16* LA = Y + (size_t)T_TOK * 1024;
  const u16* BV = (const u16*)(a.ws + OFF_KC);
  u16* YH = (u16*)(a.ws + OFF_U);
  for (int item = blockIdx.x; item < 512; item += gridDim.x) {
    const int b = item >> 4, ch = (item & 15) * 64 + lane;
    const size_t base = ((size_t)b * SEQL + w * 512) * 1024 + ch;
    float P = 1.f, H = 0.f;
    for (int t = 0; t < 512; t += 16) {
      u16 l8[16], b8[16];
#pragma unroll
      for (int i = 0; i < 16; ++i) { l8[i] = LA[base + (size_t)(t + i) * 1024]; b8[i] = BV[base + (size_t)(t + i) * 1024]; }
#pragma unroll
      for (int i = 0; i < 16; ++i) { const float av = __expf(bf2f(l8[i])); H = av * H + bf2f(b8[i]); P *= av; }
    }
    __syncthreads();
    sP[w * 64 + lane] = P; sH[w * 64 + lane] = H;
    __syncthreads();
    float h = 0.f;
    for (int s2 = 0; s2 < w; ++s2) h = sP[s2 * 64 + lane] * h + sH[s2 * 64 + lane];
    for (int t = 0; t < 512; t += 16) {
      u16 l8[16], b8[16], y8[16];
#pragma unroll
      for (int i = 0; i < 16; ++i) { const size_t idx = base + (size_t)(t + i) * 1024; l8[i] = LA[idx]; b8[i] = BV[idx]; y8[i] = Y[idx]; }
#pragma unroll
      for (int i = 0; i < 16; ++i) {
        h = __expf(bf2f(l8[i])) * h + bf2f(b8[i]);
        YH[base + (size_t)(t + i) * 1024] = f2bf(bf2f(y8[i]) * h);
      }
    }
  }
}

#define SM_SHIFT 8.0f
__device__ __forceinline__ void qk_tile(const u16* Ks, const bf16x8 (&qf)[2][2], f32x4 (&S)[4][2], int c16, int quad) {
#pragma unroll
  for (int mb = 0; mb < 4; ++mb) {
#pragma unroll
    for (int nb = 0; nb < 2; ++nb) S[mb][nb] = f32x4{-SM_SHIFT, -SM_SHIFT, -SM_SHIFT, -SM_SHIFT};
#pragma unroll
    for (int ks = 0; ks < 2; ++ks) {
      const bf16x8 kf = *(const bf16x8*)(Ks + (mb * 16 + c16) * 72 + ks * 32 + quad * 8);
#pragma unroll
      for (int nb = 0; nb < 2; ++nb) S[mb][nb] = mfma16(kf, qf[nb][ks], S[mb][nb]);
    }
  }
}
__device__ __forceinline__ void pv_tile(const u16* Vs, int koff, const f32x4 (&P)[4][2], f32x4 (&O)[4][2], int c16, int quad) {
#pragma unroll
  for (int kk = 0; kk < 2; ++kk) {
    bf16x8 pf[2];
#pragma unroll
    for (int nb = 0; nb < 2; ++nb) {
      u32x4 t;
      t.x = pack2(P[2 * kk][nb][0], P[2 * kk][nb][1]); t.y = pack2(P[2 * kk][nb][2], P[2 * kk][nb][3]);
      t.z = pack2(P[2 * kk + 1][nb][0], P[2 * kk + 1][nb][1]); t.w = pack2(P[2 * kk + 1][nb][2], P[2 * kk + 1][nb][3]);
      pf[nb] = __builtin_bit_cast(bf16x8, t);
    }
#pragma unroll
    for (int db = 0; db < 4; ++db) {
      const u16* vp = Vs + (db * 16 + c16) * 136 + koff + kk * 32 + quad * 4;
      const uint2 lo = *(const uint2*)vp, hi = *(const uint2*)(vp + 16);
      u32x4 t; t.x = lo.x; t.y = lo.y; t.z = hi.x; t.w = hi.y;
      const bf16x8 vf = __builtin_bit_cast(bf16x8, t);
#pragma unroll
      for (int nb = 0; nb < 2; ++nb) O[db][nb] = mfma16(vf, pf[nb], O[db][nb]);
    }
  }
}

template <bool NOMASK, class MaskF>
__device__ __forceinline__ void flash_step(const u16* Ks, const u16* Vs, const bf16x8 (&qf)[2][2], f32x4 (&O)[4][2], float (&m)[2], float (&l)[2],
                                           const MaskF& valid, int c16, int quad) {
  f32x4 S[4][2];
  qk_tile(Ks, qf, S, c16, quad);
#pragma unroll
  for (int nb = 0; nb < 2; ++nb) {
    float rs = 0.f;
#pragma unroll
    for (int mb = 0; mb < 4; ++mb)
#pragma unroll
      for (int j = 0; j < 4; ++j) {
        const float pv = (NOMASK || valid(nb, mb * 16 + j)) ? __builtin_amdgcn_exp2f(S[mb][nb][j]) : 0.f;
        S[mb][nb][j] = pv; rs += pv;
      }
    rs += __shfl_xor(rs, 16); rs += __shfl_xor(rs, 32);
    l[nb] += rs;
  }
  pv_tile(Vs, 0, S, O, c16, quad);
}

__device__ __forceinline__ void attn_phase(const KArgs& a, char* smem) {
  u16* Ks = (u16*)smem;
  u16* Vs = (u16*)(smem + 18432);
  float* impM = (float*)(smem + 35840);
  float* impT = (float*)(smem + 35840 + 16896);
  float* sc = (float*)(smem + 69632);
  unsigned* selm = (unsigned*)(smem + 73856);
  unsigned* anyj = selm + 32;
  const u16* Q = (const u16*)(a.ws + OFF_BUFA);
  u16* Oo = (u16*)(a.ws + OFF_BUFA) + (size_t)T_TOK * 1024;
  const float* gates = (const float*)(a.ws + OFF_GATES);
  const u16* kcmp = (const u16*)(a.ws + OFF_KCMP); const u16* vcmpt = (const u16*)(a.ws + OFF_VCMPT);
  const u16* ksl = (const u16*)(a.ws + OFF_KS); const u16* kwn = (const u16*)(a.ws + OFF_KW);
  const u16* vst = (const u16*)(a.ws + OFF_VST); const u16* vwt = (const u16*)(a.ws + OFF_VWT);

  for (int item = blockIdx.x; item < 8192; item += gridDim.x) {
    const int tid = otid(), lane = tid & 63, w = tid >> 6, c16 = lane & 15, quad = lane >> 4;
    const int qt = 63 - (item >> 7), bg = item & 127, b = bg >> 2, g = bg & 3;
    const int s0 = qt * 32, hq = g * 4 + w;
    const size_t tok0 = (size_t)b * SEQL + s0;
    bf16x8 qf[2][2];
#pragma unroll
    for (int nb = 0; nb < 2; ++nb)
#pragma unroll
      for (int ks = 0; ks < 2; ++ks) qf[nb][ks] = *(const bf16x8*)(Q + (tok0 + nb * 16 + c16) * 1024 + hq * 64 + ks * 32 + quad * 8);
    int tq[2]; tq[0] = s0 + c16; tq[1] = s0 + 16 + c16;
    f32x4 of[4][2];
#pragma unroll
    for (int db = 0; db < 4; ++db)
#pragma unroll
      for (int nb = 0; nb < 2; ++nb) of[db][nb] = f32x4{0.f, 0.f, 0.f, 0.f};

    __syncthreads();
    {
      const u16* kc = kcmp + (size_t)bg * 128 * 64;
      const u16* vc = vcmpt + (size_t)bg * 64 * 128;
#pragma unroll
      for (int i = 0; i < 4; ++i) {
        const int id = tid + i * 256;
        { const int r = id >> 3, c = id & 7; *(uint4*)(Ks + r * 72 + c * 8) = *(const uint4*)(kc + r * 64 + c * 8); }
        { const int r = id >> 4, c = id & 15; *(uint4*)(Vs + r * 136 + c * 8) = *(const uint4*)(vc + r * 128 + c * 8); }
      }
      if (tid < 32) selm[tid] = 0u;
      if (tid == 32) *anyj = 0u;
    }
    __syncthreads();
    {
      int cmax[2]; cmax[0] = ((tq[0] - 31) >> 4) - quad * 4; cmax[1] = ((tq[1] - 31) >> 4) - quad * 4;
      float lC[2] = {0.f, 0.f};
#pragma unroll
      for (int h = 0; h < 2; ++h) {
        f32x4 S[4][2];
        qk_tile(Ks + h * 64 * 72, qf, S, c16, quad);
#pragma unroll
        for (int nb = 0; nb < 2; ++nb) {
          float rs = 0.f;
#pragma unroll
          for (int mb = 0; mb < 4; ++mb)
#pragma unroll
            for (int j = 0; j < 4; ++j) rs += (h * 64 + mb * 16 + j <= cmax[nb]) ? __builtin_amdgcn_exp2f(S[mb][nb][j]) : 0.f;
          rs += __shfl_xor(rs, 16); rs += __shfl_xor(rs, 32);
          lC[nb] += rs;
        }
      }
      float invC[2]; invC[0] = (lC[0] > 0.f) ? 1.f / lC[0] : 0.f; invC[1] = (lC[1] > 0.f) ? 1.f / lC[1] : 0.f;
      f32x4 Oc[4][2];
#pragma unroll
      for (int db = 0; db < 4; ++db)
#pragma unroll
        for (int nb = 0; nb < 2; ++nb) Oc[db][nb] = f32x4{0.f, 0.f, 0.f, 0.f};
#pragma unroll
      for (int h = 0; h < 2; ++h) {
        f32x4 S[4][2];
        qk_tile(Ks + h * 64 * 72, qf, S, c16, quad);
#pragma unroll
        for (int nb = 0; nb < 2; ++nb)
#pragma unroll
          for (int mb = 0; mb < 4; ++mb) {
#pragma unroll
            for (int j = 0; j < 4; ++j)
              S[mb][nb][j] = (h * 64 + mb * 16 + j <= cmax[nb]) ? __builtin_amdgcn_exp2f(S[mb][nb][j]) * invC[nb] : 0.f;
            const int jb = h * 16 + mb * 4 + quad;
            const int idx = (w * 32 + nb * 16 + c16) * 33 + jb;
            impM[idx] = S[mb][nb][0] + S[mb][nb][1] + S[mb][nb][2] + 0.5f * S[mb][nb][3];
            impT[idx] = 0.5f * S[mb][nb][3];
          }
        pv_tile(Vs, h * 64, S, Oc, c16, quad);
      }
#pragma unroll
      for (int nb = 0; nb < 2; ++nb) {
        const float gc = gates[(tok0 + nb * 16 + c16) * 48 + hq];
#pragma unroll
        for (int db = 0; db < 4; ++db) of[db][nb] += Oc[db][nb] * gc;
      }
      __syncthreads();
      {
        const int qq = tid & 31, jg = tid >> 5;
        const int cur = (s0 + qq) >> 6;
#pragma unroll
        for (int k = 0; k < 4; ++k) {
          const int j = jg * 4 + k;
          float imp = 0.f;
#pragma unroll
          for (int ww = 0; ww < 4; ++ww) {
            imp += impM[(ww * 32 + qq) * 33 + j];
            if (j > 0) imp += impT[(ww * 32 + qq) * 33 + j - 1];
          }
          float s = imp;
          if (j > cur) s = -1e30f; else if (j == 0 || cur - j < 2) s = 1e30f;
          sc[qq * 33 + j] = s;
        }
        __syncthreads();
        unsigned bits = 0u;
#pragma unroll
        for (int k = 0; k < 4; ++k) {
          const int j = jg * 4 + k;
          const float sj = sc[qq * 33 + j];
          int cnt = 0;
          for (int i = 0; i < 32; ++i) { const float si = sc[qq * 33 + i]; cnt += (si > sj || (si == sj && i < j)) ? 1 : 0; }
          if (cnt < 16) bits |= 1u << j;
        }
        atomicOr(&selm[qq], bits);
        atomicOr(anyj, bits);
      }
    }
    __syncthreads();
    unsigned sel[2]; sel[0] = selm[c16]; sel[1] = selm[16 + c16];
    const unsigned anym = *anyj;

    {
      f32x4 O2[4][2]; float m[2] = {-1e30f, -1e30f}, l[2] = {0.f, 0.f};
#pragma unroll
      for (int db = 0; db < 4; ++db)
#pragma unroll
        for (int nb = 0; nb < 2; ++nb) O2[db][nb] = f32x4{0.f, 0.f, 0.f, 0.f};
      const int jmax = (s0 + 31) >> 6;
      unsigned rem = anym & ((2u << jmax) - 1u);
      const int r0 = tid >> 3, c0 = tid & 7;
      const u16* kbase = ksl + (size_t)bg * SEQL * 64 + r0 * 64 + c0 * 8;
      const u16* vbase = vst + (size_t)bg * 64 * SEQL + (size_t)r0 * SEQL + c0 * 8;
      uint4 rk0, rk1, rv0, rv1;
      int j = __ffs(rem) - 1;
      rk0 = *(const uint4*)(kbase + (size_t)j * 64 * 64); rk1 = *(const uint4*)(kbase + (size_t)j * 64 * 64 + 32 * 64);
      rv0 = *(const uint4*)(vbase + j * 64); rv1 = *(const uint4*)(vbase + j * 64 + (size_t)32 * SEQL);
      for (;;) {
        rem &= rem - 1u;
        __syncthreads();
        *(uint4*)(Ks + r0 * 72 + c0 * 8) = rk0; *(uint4*)(Ks + (r0 + 32) * 72 + c0 * 8) = rk1;
        *(uint4*)(Vs + r0 * 136 + c0 * 8) = rv0; *(uint4*)(Vs + (r0 + 32) * 136 + c0 * 8) = rv1;
        __syncthreads();
        const int jn = rem ? (__ffs(rem) - 1) : -1;
        if (jn >= 0) {
          rk0 = *(const uint4*)(kbase + (size_t)jn * 64 * 64); rk1 = *(const uint4*)(kbase + (size_t)jn * 64 * 64 + 32 * 64);
          rv0 = *(const uint4*)(vbase + jn * 64); rv1 = *(const uint4*)(vbase + jn * 64 + (size_t)32 * SEQL);
        }
        int lim[2];
        lim[0] = ((sel[0] >> j) & 1u) ? (tq[0] - j * 64 - quad * 4) : -1;
        lim[1] = ((sel[1] >> j) & 1u) ? (tq[1] - j * 64 - quad * 4) : -1;
        auto valid = [&](int nb, int kk) -> bool { return kk <= lim[nb]; };
        const bool full = (j * 64 + 63 <= s0) && __all((int)(((sel[0] >> j) & (sel[1] >> j)) & 1u));
        if (full) flash_step<true>(Ks, Vs, qf, O2, m, l, valid, c16, quad);
        else flash_step<false>(Ks, Vs, qf, O2, m, l, valid, c16, quad);
        if (jn < 0) break;
        j = jn;
      }
#pragma unroll
      for (int nb = 0; nb < 2; ++nb) {
        const float gs = gates[(tok0 + nb * 16 + c16) * 48 + 16 + hq] * ((l[nb] > 0.f) ? 1.f / l[nb] : 0.f);
#pragma unroll
        for (int db = 0; db < 4; ++db) of[db][nb] += O2[db][nb] * gs;
      }
    }
    {
      f32x4 O3[4][2]; float m[2] = {-1e30f, -1e30f}, l[2] = {0.f, 0.f};
#pragma unroll
      for (int db = 0; db < 4; ++db)
#pragma unroll
        for (int nb = 0; nb < 2; ++nb) O3[db][nb] = f32x4{0.f, 0.f, 0.f, 0.f};
      const int jlo = (s0 >= 511) ? ((s0 - 511) >> 6) : 0, jhi = (s0 + 31) >> 6;
      const int r0 = tid >> 3, c0 = tid & 7;
      const u16* kbase = kwn + (size_t)bg * SEQL * 64 + r0 * 64 + c0 * 8;
      const u16* vbase = vwt + (size_t)bg * 64 * SEQL + (size_t)r0 * SEQL + c0 * 8;
      uint4 rk0, rk1, rv0, rv1;
      rk0 = *(const uint4*)(kbase + (size_t)jlo * 64 * 64); rk1 = *(const uint4*)(kbase + (size_t)jlo * 64 * 64 + 32 * 64);
      rv0 = *(const uint4*)(vbase + jlo * 64); rv1 = *(const uint4*)(vbase + jlo * 64 + (size_t)32 * SEQL);
      for (int j = jlo; j <= jhi; ++j) {
        __syncthreads();
        *(uint4*)(Ks + r0 * 72 + c0 * 8) = rk0; *(uint4*)(Ks + (r0 + 32) * 72 + c0 * 8) = rk1;
        *(uint4*)(Vs + r0 * 136 + c0 * 8) = rv0; *(uint4*)(Vs + (r0 + 32) * 136 + c0 * 8) = rv1;
        __syncthreads();
        if (j < jhi) {
          const int jn = j + 1;
          rk0 = *(const uint4*)(kbase + (size_t)jn * 64 * 64); rk1 = *(const uint4*)(kbase + (size_t)jn * 64 * 64 + 32 * 64);
          rv0 = *(const uint4*)(vbase + jn * 64); rv1 = *(const uint4*)(vbase + jn * 64 + (size_t)32 * SEQL);
        }
        int lim[2]; lim[0] = tq[0] - j * 64 - quad * 4; lim[1] = tq[1] - j * 64 - quad * 4;
        auto valid = [&](int nb, int kk) -> bool { return (kk <= lim[nb]) && (kk > lim[nb] - 512); };
        const bool full = (j * 64 + 63 <= s0) && (j * 64 > s0 + 31 - 512);
        if (full) flash_step<true>(Ks, Vs, qf, O3, m, l, valid, c16, quad);
        else flash_step<false>(Ks, Vs, qf, O3, m, l, valid, c16, quad);
      }
#pragma unroll
      for (int nb = 0; nb < 2; ++nb) {
        const float gs = gates[(tok0 + nb * 16 + c16) * 48 + 32 + hq] * ((l[nb] > 0.f) ? 1.f / l[nb] : 0.f);
#pragma unroll
        for (int db = 0; db < 4; ++db) of[db][nb] += O3[db][nb] * gs;
      }
    }
#pragma unroll
    for (int nb = 0; nb < 2; ++nb)
#pragma unroll
      for (int db = 0; db < 4; ++db) {
        uint2 pk; pk.x = pack2(of[db][nb][0], of[db][nb][1]); pk.y = pack2(of[db][nb][2], of[db][nb][3]);
        *(uint2*)(Oo + (tok0 + nb * 16 + c16) * 1024 + hq * 64 + db * 16 + quad * 4) = pk;
      }
  }
}

__device__ __forceinline__ bool dbg_bad(float got, float ref) { return !(fabsf(got - ref) <= 0.03f + 0.04f * fabsf(ref)); }
__device__ __forceinline__ void check_ain(const KArgs& a) {
  const int gt = blockIdx.x * NTHREADS + otid();
  if (gt >= 65536) return;
  const unsigned s = (unsigned)gt;
  const int row = (int)(s & 31u) * 2048, col = (int)(s >> 5);
  const int b = row >> 11, ch = col & 1023;
  const u16* u = (const u16*)(a.ws + OFF_U) + (size_t)row * 1024;
  const float* w = a.in[I_AWIN] + col;
  float acc = 0.f;
  for (int k = 0; k < 1024; ++k) acc += bf2f(u[k]) * w[(size_t)k * 2048];
  const u16* Y = (const u16*)(a.ws + OFF_BUFA);
  float got, ref;
  if (col < 1024) { got = bf2f(Y[(size_t)row * 1024 + col]); ref = gelu_tanh(acc); }
  else { got = bf2f(Y[(size_t)T_TOK * 1024 + (size_t)row * 1024 + col - 1024]); ref = acc; }
  if (dbg_bad(got, ref)) { atomicAdd((unsigned*)(a.ws + OFF_FLAG), 1u); ((unsigned*)(a.ws + OFF_FLAG))[16 + ch] = 1u; ((unsigned*)(a.ws + OFF_FLAG))[1100 + b] = 1u; }

}
__device__ __forceinline__ void check_scan(const KArgs& a) {
  const int gt = blockIdx.x * NTHREADS + otid();
  if (gt >= 32768) return;
  const unsigned s = (unsigned)gt;
  const int b = (int)(s & 31u), ch = (int)(s >> 5), hd = ch >> 7;
  const u16* Y = (const u16*)(a.ws + OFF_BUFA);
  const u16* ZR = Y + (size_t)T_TOK * 1024;
  const float* gw = (const float*)(a.ws + OFF_HID);
  const float lam = a.in[I_ALAM][ch];
  const float cl = -8.f * log1pf(expf(-lam));
  float h = 0.f;
  bool bad = false;
  for (int t = 0; t < 1; ++t) {
    float g0 = a.in[I_AGATEB][ch], g1 = a.in[I_AGATEB][1024 + ch], xme = 0.f;
    for (int i = 0; i < 128; ++i) {
      const int ci = hd * 128 + i;
      float xr = a.in[I_ACONVB][ci];
      for (int k = 0; k < 4; ++k) { const int tt = t - 3 + k; if (tt >= 0) xr += a.in[I_ACONVW][k * 1024 + ci] * bf2f(ZR[((size_t)b * SEQL + tt) * 1024 + ci]); }
      g0 += xr * gw[((size_t)(0 * 8 + hd) * 128 + i) * 128 + (ch & 127)];
      g1 += xr * gw[((size_t)(1 * 8 + hd) * 128 + i) * 128 + (ch & 127)];
      if (ci == ch) xme = xr;
    }
    const float r = 1.f / (1.f + expf(-g0)), ig = 1.f / (1.f + expf(-g1));
    const float la = cl * r, av = expf(la), bt = sqrtf(fmaxf(-expm1f(2.f * la), 0.f)) * ig * xme;
    h = av * h + bt;
    const u16* u = (const u16*)(a.ws + OFF_U) + ((size_t)b * SEQL + t) * 1024;
    float acc = 0.f;
    for (int k = 0; k < 1024; ++k) acc += bf2f(u[k]) * a.in[I_AWIN][(size_t)k * 2048 + ch];
    const float ref = gelu_tanh(acc) * h;
    const float got = bf2f(Y[((size_t)b * SEQL + t) * 1024 + ch]);
    if (t == 0 && dbg_bad(got, ref)) { atomicAdd((unsigned*)(a.ws + OFF_FLAG), 1u); ((unsigned*)(a.ws + OFF_FLAG))[16 + ch] = 1u; ((unsigned*)(a.ws + OFF_FLAG))[1100 + b] = 1u; }
  }
}
__device__ __forceinline__ void check_ffn1(const KArgs& a) {
  const int gt = blockIdx.x * NTHREADS + otid();
  if (gt >= 8192) return;
  const unsigned s = (unsigned)gt;
  const int row = (int)((s * 2654435761u) >> 16), hid = (int)((s * 40503u + 17u) % 2816u);
  const u16* u = (const u16*)(a.ws + OFF_U) + (size_t)row * 1024;
  const float* w = a.in[I_FWIN];
  float g = 0.f, up = 0.f;
  for (int k = 0; k < 1024; ++k) { const float uv = bf2f(u[k]); g += uv * w[(size_t)k * 5632 + hid]; up += uv * w[(size_t)k * 5632 + 2816 + hid]; }
  const float ref = g / (1.f + expf(-g)) * up;
  const float got = bf2f(((const u16*)(a.ws + OFF_BUFA))[(size_t)row * FHID + hid]);

}
__device__ __forceinline__ void check_ffn2(const KArgs& a, const float* hold) {
}

#define N_PHASES 37
#define BISECT_HI N_PHASES

__global__ void __launch_bounds__(NTHREADS, 2) yoco_mega(KArgs a) {
  extern __shared__ __attribute__((aligned(16))) char smem[];
  cg::grid_group grid = cg::this_grid();
  char* ws = a.ws;
  volatile LDS_AS unsigned* xbst = (volatile LDS_AS unsigned*)(smem + SMEM_BYTES - 16);
  if (threadIdx.x == 0) { xbst[0] = 0u; xbst[1] = 0u; }
  __syncthreads();
  const XcdBarrier xb = xcd_barrier_post((unsigned*)(ws + OFF_BAR), xbst);
  const float* rope = (const float*)(ws + OFF_ROPE);
  int ph = 0;
#define GRID_BARRIER() { asm volatile("s_waitcnt vmcnt(0)" ::: "memory"); __builtin_amdgcn_fence(__ATOMIC_RELEASE, "agent"); asm volatile("s_waitcnt vmcnt(0)" ::: "memory"); \
    grid.sync(); __builtin_amdgcn_fence(__ATOMIC_ACQUIRE, "agent"); asm volatile("s_waitcnt vmcnt(0)" ::: "memory"); }
#define PHASE(...) { if (ph >= a.lo && ph < a.hi) { __VA_ARGS__; if (ph + 1 < a.hi) { if (a.lo < 0) { GRID_BARRIER(); } else xcd_barrier(xb); } } ++ph; }
  PHASE(prep_phase(a, smem))
  for (int layer = 0; layer < 4; ++layer) {
    if (layer < 2) {
      const int L = layer;
      const float* hin = (L == 0) ? a.in[I_X] : a.out;
      PHASE(norm_phase(hin, a.in[I_ANORM] + (size_t)L * 1024, (u16*)(ws + OFF_U)))
      PHASE({
        APlain ap{(const u16*)(ws + OFF_U), 1024};
        EpAin ep{(u16*)(ws + OFF_BUFA), (u16*)(ws + OFF_BUFA) + (size_t)T_TOK * 1024};
        gemm_phase(ap, (const u16*)(ws + OFF_W_AIN) + (size_t)L * 2048 * 1024, 1024, 512, 16, ep, smem, 4);
      })
      PHASE(conv_phase(a, L))
      PHASE(gates_phase(a, L, smem))
      PHASE(scan_phase(a, smem))
      PHASE({
        APlain ap{(const u16*)(ws + OFF_U), 1024};
        EpRes ep{hin, a.out, ABL_A};
        gemm_phase(ap, (const u16*)(ws + OFF_W_AOUT) + (size_t)L * 1024 * 1024, 1024, 512, 8, ep, smem, 8);
      })
    } else {
      const int Lb = layer - 2;
      if (Lb == 0) {
        PHASE(norm_phase(a.out, a.in[I_KVNORM], (u16*)(ws + OFF_U)))
        PHASE({
          APlain ap{(const u16*)(ws + OFF_U), 1024};
          EpKV ep{ws, a.in[I_KNORM], rope};
          gemm_phase(ap, (const u16*)(ws + OFF_W_KV), 1024, 512, 12, ep, smem, 4);
        })
        PHASE({
          for (int kv = 0; kv < 2; ++kv) {
            ACmp ap{(const u16*)(ws + (kv == 0 ? OFF_KC : OFF_VC))};
            EpCmp1 ep{(u16*)(ws + OFF_HID) + (size_t)kv * 16256 * 256, (const float*)(ws + OFF_PB) + kv * 16 * 256, a.in[I_CMPB1] + kv * 256};
            gemm_phase(ap, (const u16*)(ws + OFF_W_C1) + (size_t)kv * 256 * 2048, 2048, 127, 2, ep, smem, 2);
          }
        })
        PHASE({
          for (int kv = 0; kv < 2; ++kv) {
            APlain ap{(const u16*)(ws + OFF_HID) + (size_t)kv * 16256 * 256, 256};
            EpCmp2 ep{ws, kv, a.in[I_CMPB2] + kv * 64, a.in[I_KNORM], rope};
            gemm_phase(ap, (const u16*)(ws + OFF_W_C2) + (size_t)kv * 128 * 256, 256, 127, 1, ep, smem, 1);
          }
        })
      }
      PHASE(norm_phase(a.out, a.in[I_BNORM] + (size_t)Lb * 1024, (u16*)(ws + OFF_U)))
      PHASE({
        APlain ap{(const u16*)(ws + OFF_U), 1024};
        EpQ ep{(u16*)(ws + OFF_BUFA), (float*)(ws + OFF_GATES), a.in[I_QNORM] + Lb * 64, a.in[I_BGATEB] + Lb * 48, rope};
        gemm_phase(ap, (const u16*)(ws + OFF_W_BIN) + (size_t)Lb * 1152 * 1024, 1024, 512, 9, ep, smem, 3);
      })
      PHASE(attn_phase(a, smem))
      PHASE({
        APlain ap{(const u16*)(ws + OFF_BUFA) + (size_t)T_TOK * 1024, 1024};
        EpRes ep{a.out, a.out, ABL_B};
        gemm_phase(ap, (const u16*)(ws + OFF_W_BOUT) + (size_t)Lb * 1024 * 1024, 1024, 512, 8, ep, smem, 8);
      })
    }
    PHASE(norm_phase(a.out, a.in[I_FNORM] + (size_t)layer * 1024, (u16*)(ws + OFF_U)))
    PHASE({
      APlain ap{(const u16*)(ws + OFF_U), 1024};
      EpFfn1 ep{(u16*)(ws + OFF_BUFA)};
      gemm_phase(ap, (const u16*)(ws + OFF_W_FIN) + (size_t)layer * 5632 * 1024, 1024, 512, 44, ep, smem, 4);
    })
    PHASE({
      APlain ap{(const u16*)(ws + OFF_BUFA), FHID};
      EpRes ep{a.out, a.out, ABL_F};
      gemm_phase(ap, (const u16*)(ws + OFF_W_FOUT) + (size_t)layer * 1024 * FHID, FHID, 512, 8, ep, smem, 8);
    })
  }
#undef PHASE
}

extern "C" void kernel_launch(void* const* d_in, const int* in_sizes, int n_in, void* d_out, int out_size, void* d_ws, size_t ws_size,
                              hipStream_t stream) {
  static int grid_blocks = 0;
  if (!grid_blocks) {
    int dev = 0, cus = 0, per_cu = 0;
    hipGetDevice(&dev);
    hipDeviceGetAttribute(&cus, hipDeviceAttributeMultiprocessorCount, dev);
    if (hipFuncSetAttribute((const void*)yoco_mega, hipFuncAttributeMaxDynamicSharedMemorySize, SMEM_BYTES) != hipSuccess) fprintf(stderr, "hipFuncSetAttribute failed\n");
    hipOccupancyMaxActiveBlocksPerMultiprocessor(&per_cu, (const void*)yoco_mega, NTHREADS, SMEM_BYTES);
    if (per_cu < 1) per_cu = 1;
    if (per_cu > 2) per_cu = 2;
    grid_blocks = cus * per_cu;
  }
  if (ws_size < WS_END) { fprintf(stderr, "ws too small: %zu < %zu\n", ws_size, (size_t)WS_END); return; }
  { static const int exp_sizes[25] = {65536*1024, 2*1024, 2*1024*2048, 2*4*1024, 2*1024, 2*2*8*128*128, 2*2*1024, 2*1024, 2*1024*1024, 1024, 1024*1536, 3*64, 2*32*64, 2*2048*256, 2*256, 2*256*64, 2*64, 2*1024, 2*1024*1072, 2*48, 2*64, 2*1024*1024, 4*1024, 4*1024*5632, 4*2816*1024};
    if (n_in != 25) return;
    for (int i = 0; i < 25; ++i) if (in_sizes[i] != exp_sizes[i]) { fprintf(stderr, "in_sizes[%d] = %d, expected %d\n", i, in_sizes[i], exp_sizes[i]); return; } }
  KArgs a{};
  for (int i = 0; i < 25; ++i) a.in[i] = (const float*)d_in[i];
  a.out = (float*)d_out;
  a.ws = (char*)d_ws;
  hipMemsetAsync((char*)d_ws + OFF_BAR, 0, XCD_BAR_BYTES, stream);
  hipMemcpyAsync((char*)d_ws + OFF_HID, d_in[5], (size_t)in_sizes[5] * 4, hipMemcpyDeviceToDevice, stream);
#ifdef MULTI_LAUNCH
  for (int ph = 0; ph < N_PHASES; ++ph) {
    a.lo = ph; a.hi = ph + 1;
    hipLaunchKernelGGL(yoco_mega, dim3(grid_blocks), dim3(NTHREADS), SMEM_BYTES, stream, a);
  }
#else
  a.lo = 0; a.hi = BISECT_HI;
  void* args[] = {&a};
  hipError_t e = hipLaunchCooperativeKernel((void*)yoco_mega, dim3(grid_blocks), dim3(NTHREADS), args, SMEM_BYTES, stream);
  if (e != hipSuccess) fprintf(stderr, "cooperative launch failed: %s (grid %d)\n", hipGetErrorString(e), grid_blocks);
#endif
}
```

```cpp
#include <hip/hip_runtime.h>
#include <hip/hip_cooperative_groups.h>
#include <cstdio>
#include <cstdint>
namespace cg = cooperative_groups;

typedef unsigned short u16;
typedef short bf16x8 __attribute__((ext_vector_type(8)));
typedef float f32x4 __attribute__((ext_vector_type(4)));
typedef unsigned u32x4 __attribute__((ext_vector_type(4)));

#define T_TOK 65536
#define SEQL 2048
#define FHID 2816
#define NTHREADS 256
#define XCD_BAR_BYTES 16384
#define SMEM_BYTES 74240
#ifndef ABL_A
#define ABL_A 1.f
#endif
#ifndef ABL_B
#define ABL_B 1.f
#endif
#ifndef ABL_F
#define ABL_F 1.f
#endif
#define PREP_TILES (1024 + 512 + 384 + 256 + 16 + 576 + 512 + 5632 + 2816)

constexpr size_t OFF_W_AIN  = 0;
constexpr size_t OFF_W_GATE = OFF_W_AIN  + (size_t)2 * 2048 * 1024 * 2;
constexpr size_t OFF_W_AOUT = OFF_W_GATE + (size_t)64 * 128 * 128 * 2;
constexpr size_t OFF_W_KV   = OFF_W_AOUT + (size_t)2 * 1024 * 1024 * 2;
constexpr size_t OFF_W_C1   = OFF_W_KV   + (size_t)1536 * 1024 * 2;
constexpr size_t OFF_W_C2   = OFF_W_C1   + (size_t)2 * 256 * 2048 * 2;
constexpr size_t OFF_W_BIN  = OFF_W_C2   + (size_t)2 * 128 * 256 * 2;
constexpr size_t OFF_W_BOUT = OFF_W_BIN  + (size_t)2 * 1152 * 1024 * 2;
constexpr size_t OFF_W_FIN  = OFF_W_BOUT + (size_t)2 * 1024 * 1024 * 2;
constexpr size_t OFF_W_FOUT = OFF_W_FIN  + (size_t)4 * 5632 * 1024 * 2;
constexpr size_t OFF_ROPE   = OFF_W_FOUT + (size_t)4 * 1024 * 2816 * 2;
constexpr size_t OFF_PB     = OFF_ROPE   + (size_t)2048 * 32 * 2 * 4;
constexpr size_t OFF_U      = OFF_PB     + (size_t)2 * 16 * 256 * 4;
constexpr size_t OFF_BUFA   = OFF_U      + (size_t)T_TOK * 1024 * 2;
constexpr size_t OFF_KC     = OFF_BUFA   + (size_t)T_TOK * FHID * 2;
constexpr size_t OFF_VC     = OFF_KC     + (size_t)T_TOK * 256 * 2;
constexpr size_t OFF_KS     = OFF_VC     + (size_t)T_TOK * 256 * 2;
constexpr size_t OFF_KW     = OFF_KS     + (size_t)T_TOK * 256 * 2;
constexpr size_t OFF_VST    = OFF_KW     + (size_t)T_TOK * 256 * 2;
constexpr size_t OFF_VWT    = OFF_VST    + (size_t)T_TOK * 256 * 2;
constexpr size_t OFF_KCMP   = OFF_VWT    + (size_t)T_TOK * 256 * 2;
constexpr size_t OFF_VCMPT  = OFF_KCMP   + (size_t)128 * 128 * 64 * 2;
constexpr size_t OFF_HID    = OFF_VCMPT  + (size_t)128 * 64 * 128 * 2;
constexpr size_t OFF_GATES  = OFF_HID    + (size_t)2 * 16256 * 256 * 2;
#define OFF_FLAG (OFF_GATES + (size_t)T_TOK * 48 * 4)
#define OFF_BAR (OFF_FLAG + 16384)
constexpr size_t WS_END     = OFF_GATES  + (size_t)T_TOK * 48 * 4 + 16384 + XCD_BAR_BYTES;

struct KArgs {
  const float* in[25];
  float* out;
  char* ws;
  int lo, hi;
};
enum { I_X = 0, I_ANORM, I_AWIN, I_ACONVW, I_ACONVB, I_AGATEW, I_AGATEB, I_ALAM, I_AWOUT, I_KVNORM, I_KVW, I_KNORM,
       I_CMPPOS, I_CMPW1, I_CMPB1, I_CMPW2, I_CMPB2, I_BNORM, I_BWIN, I_BGATEB, I_QNORM, I_BWOUT, I_FNORM, I_FWIN, I_FWOUT };

__device__ __forceinline__ unsigned pack2(float lo, float hi) { unsigned r; asm("v_cvt_pk_bf16_f32 %0, %1, %2" : "=v"(r) : "v"(lo), "v"(hi)); return r; }
__device__ __forceinline__ u16 f2bf(float f) { return (u16)pack2(f, f); }
__device__ __forceinline__ float bf2f(u16 h) { return __uint_as_float(((unsigned)h) << 16); }
__device__ __forceinline__ float sigmoidf_(float x) { return 1.f / (1.f + __expf(-x)); }
__device__ __forceinline__ float gelu_tanh(float x) { float u = 0.7978845608028654f * (x + 0.044715f * x * x * x); return x / (1.f + __expf(-2.f * u)); }
__device__ __forceinline__ f32x4 mfma16(bf16x8 a, bf16x8 b, f32x4 c) { return __builtin_amdgcn_mfma_f32_16x16x32_bf16(a, b, c, 0, 0, 0); }

__device__ __forceinline__ int otid() { int t = threadIdx.x; asm volatile("" : "+v"(t)); return t; }

#define LDS_AS __attribute__((address_space(3)))
struct APlain {
  const u16* A; int lda;
  __device__ __forceinline__ const u16* rowptr(int row) const { return A + (size_t)row * lda; }
  __device__ __forceinline__ int kstride() const { return 64; }
};
struct ACmp {
  const u16* kc;
  __device__ __forceinline__ const u16* rowptr(int row) const {
    const int g = row & 3, bc = row >> 2, b = bc / 127, c = bc - b * 127;
    return kc + ((size_t)(b * SEQL + c * 16) * 256 + g * 64);
  }
  __device__ __forceinline__ int kstride() const { return 256; }
};

template <class AP, class EP>
__device__ __forceinline__ void gemm_tile(const AP& ap, const u16* __restrict__ Bt, int K, int m0, int n0, const EP& ep, char* smem) {
  const int tid = otid(), lane = tid & 63, w = tid >> 6, wm = w >> 1, wn = w & 1, c16 = lane & 15, quad = lane >> 4;
  const int nk = K >> 6;
  const int srow = lane >> 2;
  const int scol = (w & 1) * 32 + ((((lane & 3) * 16) ^ ((lane >> 5) << 5)) >> 1);
  const u16* ga[4]; const u16* gb[4];
#pragma unroll
  for (int p = 0; p < 4; ++p) {
    const int R = ((w >> 1) + 2 * p) * 16 + srow;
    ga[p] = ap.rowptr(m0 + R) + scol;
    gb[p] = Bt + (size_t)(n0 + R) * K + scol;
  }
  const int kstr = ap.kstride();
  const int lofs = (c16 * 64 + quad * 16) ^ ((c16 >> 3) << 5);
  f32x4 acc[4][4];
#pragma unroll
  for (int i = 0; i < 4; ++i)
#pragma unroll
    for (int j = 0; j < 4; ++j) acc[i][j] = f32x4{0.f, 0.f, 0.f, 0.f};

#define GSTAGE(buf_, kt_)                                                                                                        \
  _Pragma("unroll") for (int p = 0; p < 4; ++p) {                                                                                \
    __builtin_amdgcn_global_load_lds((const unsigned*)(ga[p] + (size_t)(kt_) * kstr),                                            \
                                     (LDS_AS unsigned*)(smem + (buf_) * 32768 + w * 1024 + p * 4096), 16, 0, 0);                 \
    __builtin_amdgcn_global_load_lds((const unsigned*)(gb[p] + (size_t)(kt_) * 64),                                              \
                                     (LDS_AS unsigned*)(smem + (buf_) * 32768 + 16384 + w * 1024 + p * 4096), 16, 0, 0);         \
  }
  GSTAGE(0, 0);
  asm volatile("s_waitcnt vmcnt(0)" ::: "memory");
  __syncthreads();
  for (int kt = 0; kt < nk; ++kt) {
    const int cur = kt & 1;
    if (kt + 1 < nk) { GSTAGE(cur ^ 1, kt + 1); }
    const char* pa = smem + cur * 32768 + (wm * 8) * 1024 + lofs;
    const char* pb = smem + cur * 32768 + 16384 + (wn * 8) * 1024 + lofs;
#pragma unroll
    for (int ks = 0; ks < 2; ++ks) {
      bf16x8 af[4], bfr[4];
#pragma unroll
      for (int i = 0; i < 4; ++i) { af[i] = *(const bf16x8*)(pa + (i * 2 + ks) * 1024); bfr[i] = *(const bf16x8*)(pb + (i * 2 + ks) * 1024); }
      __builtin_amdgcn_s_setprio(1);
#pragma unroll
      for (int i = 0; i < 4; ++i)
#pragma unroll
        for (int j = 0; j < 4; ++j) acc[i][j] = EP::TR ? mfma16(bfr[j], af[i], acc[i][j]) : mfma16(af[i], bfr[j], acc[i][j]);
      __builtin_amdgcn_s_setprio(0);
    }
    __builtin_amdgcn_sched_barrier(0);
    asm volatile("s_waitcnt vmcnt(0)" ::: "memory");
    __syncthreads();
  }
#undef GSTAGE
  ep(acc, m0 + wm * 64, n0 + wn * 64, lane);
}

__device__ __forceinline__ bool super_tile(int it, int mtiles, int ntiles, int SN, int& m, int& n) {
  const int nbx = gridDim.x >> 3, x = blockIdx.x & 7, lb = blockIdx.x >> 3;
  const int SM = nbx / SN, scols = (ntiles + SN - 1) / SN;
  const int s = x + 8 * it, sr = s / scols, sc = s - sr * scols;
  m = sr * SM + (lb % SM); n = sc * SN + (lb / SM);
  return (lb < SM * SN) && (m < mtiles) && (n < ntiles);
}
__device__ __forceinline__ int super_iters(int mtiles, int ntiles, int SN) {
  const int nbx = gridDim.x >> 3, SM = nbx / SN;
  const int nsuper = ((ntiles + SN - 1) / SN) * ((mtiles + SM - 1) / SM);
  return (nsuper + 7) >> 3;
}
template <class AP, class EP>
__device__ __forceinline__ void gemm_phase(const AP& ap, const u16* Bt, int K, int mtiles, int ntiles, const EP& ep, char* smem, int SN) {
  const int iters = super_iters(mtiles, ntiles, SN);
  for (int it = 0; it < iters; ++it) {
    int m, n;
    if (super_tile(it, mtiles, ntiles, SN, m, n)) gemm_tile(ap, Bt, K, m * 128, n * 128, ep, smem);
  }
}


__device__ __forceinline__ void head_norm_rope(float (&v)[4], const float* __restrict__ gain, const float* __restrict__ rope, int pos, int c16, float outscale) {
  float ss = v[0] * v[0] + v[1] * v[1] + v[2] * v[2] + v[3] * v[3];
  ss += __shfl_xor(ss, 1); ss += __shfl_xor(ss, 2); ss += __shfl_xor(ss, 4); ss += __shfl_xor(ss, 8);
  const float rs = rsqrtf(ss * (1.f / 64.f) + 1e-6f) * outscale;
  const float y0 = v[0] * rs * gain[c16], y1 = v[1] * rs * gain[16 + c16], y2 = v[2] * rs * gain[32 + c16], y3 = v[3] * rs * gain[48 + c16];
  const float2 cs0 = *(const float2*)(rope + ((size_t)pos * 32 + c16) * 2);
  const float2 cs1 = *(const float2*)(rope + ((size_t)pos * 32 + 16 + c16) * 2);
  v[0] = y0 * cs0.x - y2 * cs0.y; v[2] = y0 * cs0.y + y2 * cs0.x;
  v[1] = y1 * cs1.x - y3 * cs1.y; v[3] = y1 * cs1.y + y3 * cs1.x;
}

struct EpAin {
  static constexpr bool TR = true;
  u16* y; u16* zr;
  __device__ __forceinline__ void operator()(f32x4 (&acc)[4][4], int mb, int nb, int lane) const {
    const int c16 = lane & 15, quad = lane >> 4;
#pragma unroll
    for (int mi = 0; mi < 4; ++mi)
#pragma unroll
      for (int ni = 0; ni < 4; ++ni) {
        const int row = mb + mi * 16 + c16, col = nb + ni * 16 + quad * 4;
        uint2 pk;
        if (nb < 1024) {
          pk.x = pack2(gelu_tanh(acc[mi][ni][0]), gelu_tanh(acc[mi][ni][1])); pk.y = pack2(gelu_tanh(acc[mi][ni][2]), gelu_tanh(acc[mi][ni][3]));
          *(uint2*)(y + (size_t)row * 1024 + col) = pk;
        } else {
          pk.x = pack2(acc[mi][ni][0], acc[mi][ni][1]); pk.y = pack2(acc[mi][ni][2], acc[mi][ni][3]);
          *(uint2*)(zr + (size_t)row * 1024 + col - 1024) = pk;
        }
      }
  }
};
struct EpRes {
  static constexpr bool TR = true;
  const float* res; float* out; float sc;
  __device__ __forceinline__ void operator()(f32x4 (&acc)[4][4], int mb, int nb, int lane) const {
    const int c16 = lane & 15, quad = lane >> 4;
#pragma unroll
    for (int mi = 0; mi < 4; ++mi)
#pragma unroll
      for (int ni = 0; ni < 4; ++ni) {
        const size_t idx = (size_t)(mb + mi * 16 + c16) * 1024 + nb + ni * 16 + quad * 4;
        const float4 r = *(const float4*)(res + idx);
        float4 o; o.x = r.x + sc * acc[mi][ni][0]; o.y = r.y + sc * acc[mi][ni][1]; o.z = r.z + sc * acc[mi][ni][2]; o.w = r.w + sc * acc[mi][ni][3];
        *(float4*)(out + idx) = o;
      }
  }
};
struct EpFfn1 {
  static constexpr bool TR = true;
  u16* act;
  __device__ __forceinline__ void operator()(f32x4 (&acc)[4][4], int mb, int nb, int lane) const {
    const int c16 = lane & 15, quad = lane >> 4;
    const int hb = (nb >> 6) * 32;
#pragma unroll
    for (int mi = 0; mi < 4; ++mi)
#pragma unroll
      for (int ni = 0; ni < 2; ++ni) {
        float v[4];
#pragma unroll
        for (int jj = 0; jj < 4; ++jj) { const float g = acc[mi][ni][jj], u = acc[mi][ni + 2][jj]; v[jj] = g / (1.f + __expf(-g)) * u; }
        uint2 pk; pk.x = pack2(v[0], v[1]); pk.y = pack2(v[2], v[3]);
        *(uint2*)(act + (size_t)(mb + mi * 16 + c16) * FHID + hb + ni * 16 + quad * 4) = pk;
      }
  }
};
struct EpKV {
  static constexpr bool TR = false;
  char* ws; const float* knorm; const float* rope;
  __device__ __forceinline__ void operator()(f32x4 (&acc)[4][4], int mb, int nb, int lane) const {
    const int c16 = lane & 15, quad = lane >> 4;
    const int j6 = nb >> 8, g = (nb & 255) >> 6;
    const int b = mb / SEQL, sb = mb - b * SEQL;
    if (j6 < 2) {
      u16* dst = (u16*)(ws + (j6 == 0 ? OFF_KC : OFF_VC));
#pragma unroll
      for (int mi = 0; mi < 4; ++mi)
#pragma unroll
        for (int ni = 0; ni < 4; ++ni)
#pragma unroll
          for (int j = 0; j < 4; ++j)
            dst[(size_t)(mb + mi * 16 + quad * 4 + j) * 256 + g * 64 + ni * 16 + c16] = f2bf(acc[mi][ni][j]);
    } else if (j6 == 2 || j6 == 4) {
      u16* dst = (u16*)(ws + (j6 == 2 ? OFF_KS : OFF_KW));
      const float* gain = knorm + (j6 == 2 ? 64 : 128);
#pragma unroll
      for (int mi = 0; mi < 4; ++mi)
#pragma unroll
        for (int j = 0; j < 4; ++j) {
          const int s = sb + mi * 16 + quad * 4 + j;
          float v[4] = {acc[mi][0][j], acc[mi][1][j], acc[mi][2][j], acc[mi][3][j]};
          head_norm_rope(v, gain, rope, s, c16, 1.f);
#pragma unroll
          for (int ni = 0; ni < 4; ++ni) dst[((size_t)(b * 4 + g) * SEQL + s) * 64 + ni * 16 + c16] = f2bf(v[ni]);
        }
    } else {
      u16* dst = (u16*)(ws + (j6 == 3 ? OFF_VST : OFF_VWT));
#pragma unroll
      for (int mi = 0; mi < 4; ++mi)
#pragma unroll
        for (int ni = 0; ni < 4; ++ni) {
          const int d = ni * 16 + c16, s = sb + mi * 16 + quad * 4;
          uint2 pk; pk.x = pack2(acc[mi][ni][0], acc[mi][ni][1]); pk.y = pack2(acc[mi][ni][2], acc[mi][ni][3]);
          *(uint2*)(dst + ((size_t)(b * 4 + g) * 64 + d) * SEQL + s) = pk;
        }
    }
  }
};
struct EpCmp1 {
  static constexpr bool TR = false;
  u16* hid; const float* pbpart; const float* b1;
  __device__ __forceinline__ void operator()(f32x4 (&acc)[4][4], int mb, int nb, int lane) const {
    const int c16 = lane & 15, quad = lane >> 4;
#pragma unroll
    for (int ni = 0; ni < 4; ++ni) {
      const int col = nb + ni * 16 + c16;
      float pb = b1[col];
      for (int s = 0; s < 16; ++s) pb += pbpart[s * 256 + col];
#pragma unroll
      for (int mi = 0; mi < 4; ++mi)
#pragma unroll
        for (int j = 0; j < 4; ++j)
          hid[(size_t)(mb + mi * 16 + quad * 4 + j) * 256 + col] = f2bf(gelu_tanh(acc[mi][ni][j] + pb));
    }
  }
};
struct EpCmp2 {
  static constexpr bool TR = false;
  char* ws; int kv; const float* b2; const float* knorm; const float* rope;
  __device__ __forceinline__ void operator()(f32x4 (&acc)[4][4], int mb, int nb, int lane) const {
    if (nb & 64) return;
    const int c16 = lane & 15, quad = lane >> 4;
    float bb[4];
#pragma unroll
    for (int ni = 0; ni < 4; ++ni) bb[ni] = b2[ni * 16 + c16];
#pragma unroll
    for (int mi = 0; mi < 4; ++mi)
#pragma unroll
      for (int j = 0; j < 4; ++j) {
        const int row = mb + mi * 16 + quad * 4 + j;
        const int g = row & 3, bc = row >> 2, b = bc / 127, c = bc - b * 127;
        float v[4] = {acc[mi][0][j] + bb[0], acc[mi][1][j] + bb[1], acc[mi][2][j] + bb[2], acc[mi][3][j] + bb[3]};
        if (kv == 0) {
          head_norm_rope(v, knorm, rope, c * 16 + 31, c16, 1.f);
          u16* dst = (u16*)(ws + OFF_KCMP) + ((size_t)(b * 4 + g) * 128 + c) * 64;
#pragma unroll
          for (int ni = 0; ni < 4; ++ni) dst[ni * 16 + c16] = f2bf(v[ni]);
        } else {
          u16* dst = (u16*)(ws + OFF_VCMPT) + (size_t)(b * 4 + g) * 64 * 128 + c;
#pragma unroll
          for (int ni = 0; ni < 4; ++ni) dst[(size_t)(ni * 16 + c16) * 128] = f2bf(v[ni]);
        }
      }
  }
};
__device__ __forceinline__ void head_norm_rope_t(float (&v)[4][4], const float* __restrict__ gain, const float* __restrict__ rope, int pos, int quad, float outscale) {
  float ss = 0.f;
#pragma unroll
  for (int ni = 0; ni < 4; ++ni)
#pragma unroll
    for (int jj = 0; jj < 4; ++jj) ss += v[ni][jj] * v[ni][jj];
  ss += __shfl_xor(ss, 16); ss += __shfl_xor(ss, 32);
  const float rs = rsqrtf(ss * (1.f / 64.f) + 1e-6f) * outscale;
#pragma unroll
  for (int ni = 0; ni < 2; ++ni) {
    const int d = ni * 16 + quad * 4;
    const float4 g1 = *(const float4*)(gain + d), g2 = *(const float4*)(gain + d + 32);
    const float4 csa = *(const float4*)(rope + ((size_t)pos * 32 + d) * 2), csb = *(const float4*)(rope + ((size_t)pos * 32 + d) * 2 + 4);
    const float g1a[4] = {g1.x, g1.y, g1.z, g1.w}, g2a[4] = {g2.x, g2.y, g2.z, g2.w};
    const float cc[4] = {csa.x, csa.z, csb.x, csb.z}, sn[4] = {csa.y, csa.w, csb.y, csb.w};
#pragma unroll
    for (int jj = 0; jj < 4; ++jj) {
      const float y1 = v[ni][jj] * rs * g1a[jj], y2 = v[ni + 2][jj] * rs * g2a[jj];
      v[ni][jj] = y1 * cc[jj] - y2 * sn[jj];
      v[ni + 2][jj] = y1 * sn[jj] + y2 * cc[jj];
    }
  }
}
struct EpQ {
  static constexpr bool TR = true;
  u16* q; float* gates; const float* qnorm; const float* gate_b; const float* rope;
  __device__ __forceinline__ void operator()(f32x4 (&acc)[4][4], int mb, int nb, int lane) const {
    const int c16 = lane & 15, quad = lane >> 4;
    if (nb < 1024) {
      const float osc = 0.125f * 1.4426950408889634f;
#pragma unroll
      for (int mi = 0; mi < 4; ++mi) {
        const int row = mb + mi * 16 + c16;
        float v[4][4];
#pragma unroll
        for (int ni = 0; ni < 4; ++ni)
#pragma unroll
          for (int jj = 0; jj < 4; ++jj) v[ni][jj] = acc[mi][ni][jj];
        head_norm_rope_t(v, qnorm, rope, row & (SEQL - 1), quad, osc);
#pragma unroll
        for (int ni = 0; ni < 4; ++ni) {
          uint2 pk; pk.x = pack2(v[ni][0], v[ni][1]); pk.y = pack2(v[ni][2], v[ni][3]);
          *(uint2*)(q + (size_t)row * 1024 + nb + ni * 16 + quad * 4) = pk;
        }
      }
    } else if (nb == 1024) {
#pragma unroll
      for (int ni = 0; ni < 3; ++ni) {
        const int gi = ni * 16 + quad * 4;
        const float4 gb = *(const float4*)(gate_b + gi);
#pragma unroll
        for (int mi = 0; mi < 4; ++mi) {
          float4 o;
          o.x = sigmoidf_(acc[mi][ni][0] + gb.x); o.y = sigmoidf_(acc[mi][ni][1] + gb.y);
          o.z = sigmoidf_(acc[mi][ni][2] + gb.z); o.w = sigmoidf_(acc[mi][ni][3] + gb.w);
          *(float4*)(gates + (size_t)(mb + mi * 16 + c16) * 48 + gi) = o;
        }
      }
    }
  }
};

#define XB_TMO      128
#define XB_XCNT(j)  (256  + 64 * (j))
#define XB_XSUB(j)  (1280 + 64 * (j))
#define XB_XGEN(j)  (2304 + 64 * (j))
#define XB_TOP      3328
#define XB_TOPGEN   3392
#define XCD_BAR_WORDS 3456
#define XB_SPIN_CAP (1u << 22)
__device__ __forceinline__ unsigned xb_ld(unsigned* p)              { return __hip_atomic_load(p, __ATOMIC_RELAXED, __HIP_MEMORY_SCOPE_AGENT); }
__device__ __forceinline__ unsigned xb_add(unsigned* p, unsigned v) { return __hip_atomic_fetch_add(p, v, __ATOMIC_RELAXED, __HIP_MEMORY_SCOPE_AGENT); }
__device__ __forceinline__ unsigned xb_xcc_id() { return (unsigned)__builtin_amdgcn_s_getreg((3 << 11) | 20) & 0xFu; }
#define XB_SPIN(cond, bar) do { unsigned _sp = 0; while (cond) { __builtin_amdgcn_s_sleep(1); \
    if ((++_sp & 255u) == 0u) { if (xb_ld(&(bar)[XB_TMO])) break; if (_sp > XB_SPIN_CAP) { atomicAdd(&(bar)[XB_TMO], 1u); break; } } } } while (0)
struct XcdBarrier { unsigned* bar; unsigned x; volatile LDS_AS unsigned* st; };
__device__ __forceinline__ XcdBarrier xcd_barrier_post(unsigned* bar, volatile LDS_AS unsigned* st) {
  XcdBarrier b; b.bar = bar; b.x = xb_xcc_id(); b.st = st;
  if (threadIdx.x == 0) (void)xb_add(&bar[XB_XCNT(b.x)], 1u);
  return b;
}
__device__ __forceinline__ void xcd_barrier_complete(unsigned* bar, unsigned x, unsigned& nloc, unsigned& nx) {
  const unsigned G = gridDim.x * gridDim.y * gridDim.z;
  unsigned sum, cnt, mine, sp = 0u;
  for (;;) {
    sum = 0u; cnt = 0u; mine = 0u;
#pragma unroll
    for (unsigned j = 0; j < 16; ++j) { const unsigned c = xb_ld(&bar[XB_XCNT(j)]); sum += c; cnt += (c > 0u) ? 1u : 0u; mine = (j == x) ? c : mine; }
    if (sum == G) break;
    __builtin_amdgcn_s_sleep(1);
    if ((++sp & 255u) == 0u) { if (xb_ld(&bar[XB_TMO])) break; if (sp > XB_SPIN_CAP) { atomicAdd(&bar[XB_TMO], 1u); break; } }
  }
  nloc = mine > 0u ? mine : 1u; nx = cnt > 0u ? cnt : 1u;
}
__device__ __forceinline__ void xcd_barrier(const XcdBarrier& b) {
  asm volatile("s_waitcnt vmcnt(0)" ::: "memory");
  __syncthreads();
  if (threadIdx.x == 0) {
    unsigned* bar = b.bar;
    __builtin_amdgcn_s_waitcnt(0);
    unsigned nloc = b.st[0], nx = b.st[1];
    if (nloc == 0u) { xcd_barrier_complete(bar, b.x, nloc, nx); b.st[0] = nloc; b.st[1] = nx; }
    const unsigned old = xb_add(&bar[XB_XSUB(b.x)], 1u);
    const unsigned gen = old / nloc;
    if (old + 1u == (gen + 1u) * nloc) {
      __builtin_amdgcn_fence(__ATOMIC_RELEASE, "agent");
      asm volatile("s_waitcnt vmcnt(0)" ::: "memory");
      const unsigned og = xb_add(&bar[XB_TOP], 1u);
      const unsigned tg = og / nx;
      if (og + 1u == (tg + 1u) * nx) xb_add(&bar[XB_TOPGEN], 1u);
      else XB_SPIN(xb_ld(&bar[XB_TOPGEN]) == tg, bar);
      __builtin_amdgcn_fence(__ATOMIC_ACQUIRE, "agent");
      xb_add(&bar[XB_XGEN(b.x)], 1u);
      asm volatile("s_waitcnt vmcnt(0)" ::: "memory");
    } else {
      XB_SPIN(xb_ld(&bar[XB_XGEN(b.x)]) == gen, bar);
      __builtin_amdgcn_fence(__ATOMIC_ACQUIRE, "agent");
      asm volatile("s_waitcnt vmcnt(0)" ::: "memory");
    }
  }
  __syncthreads();
}

__device__ __forceinline__ void norm_phase(const float* __restrict__ h, const float* __restrict__ g, u16* __restrict__ u) {
  const int tidn = otid();
  const int lane = tidn & 63;
  const int gw = blockIdx.x * 4 + (tidn >> 6), nw = gridDim.x * 4;
  float4 gv[4];
#pragma unroll
  for (int i = 0; i < 4; ++i) gv[i] = *(const float4*)(g + i * 256 + lane * 4);
  for (int row = gw; row < T_TOK; row += nw) {
    const float* hr = h + (size_t)row * 1024;
    float4 v[4];
    float ss = 0.f;
#pragma unroll
    for (int i = 0; i < 4; ++i) { { const f32x4 t_ = __builtin_nontemporal_load((const f32x4*)(hr + i * 256 + lane * 4)); v[i] = make_float4(t_[0], t_[1], t_[2], t_[3]); } ss += v[i].x * v[i].x + v[i].y * v[i].y + v[i].z * v[i].z + v[i].w * v[i].w; }
#pragma unroll
    for (int o = 32; o >= 1; o >>= 1) ss += __shfl_xor(ss, o);
    const float rs = rsqrtf(ss * (1.f / 1024.f) + 1e-6f);
#pragma unroll
    for (int i = 0; i < 4; ++i) {
      uint2 pk; pk.x = pack2(v[i].x * rs * gv[i].x, v[i].y * rs * gv[i].y); pk.y = pack2(v[i].z * rs * gv[i].z, v[i].w * rs * gv[i].w);
      *(uint2*)(u + (size_t)row * 1024 + i * 256 + lane * 4) = pk;
    }
  }
}

__device__ __forceinline__ void do_transpose(const float* __restrict__ src, u16* __restrict__ dst, int K, int N, int Nd, int mode, int t, char* smem) {
  float* tile = (float*)smem;
  const int tid = otid();
  const int ktn = K >> 6, tpb = ktn * (Nd >> 6);
  const int bi = t / tpb, r = t - bi * tpb, nt = r / ktn, kt = r - nt * ktn;
  const float* sb = src + (size_t)bi * K * N;
  u16* db = dst + (size_t)bi * Nd * K;
  __syncthreads();
#pragma unroll 4
  for (int i = 0; i < 16; ++i) {
    const int e = tid + i * 256, kk = e >> 6, nn = e & 63;
    const int n1 = nt * 64 + nn;
    int sc = n1;
    if (mode == 1) { const int blk = n1 >> 6, rr = n1 & 63; const int hid = blk * 32 + (rr & 31); sc = (rr < 32) ? hid : (FHID + hid); }
    tile[kk * 65 + nn] = (sc < N) ? sb[(size_t)(kt * 64 + kk) * N + sc] : 0.f;
  }
  __syncthreads();
#pragma unroll 4
  for (int i = 0; i < 16; ++i) {
    const int e = tid + i * 256, nn = e >> 6, kk = e & 63;
    db[(size_t)(nt * 64 + nn) * K + kt * 64 + kk] = f2bf(tile[kk * 65 + nn]);
  }
}

__device__ __forceinline__ void prep_phase(const KArgs& a, char* smem) {
  char* ws = a.ws;
  constexpr int TOTAL = PREP_TILES;
  for (int tile = blockIdx.x; tile < TOTAL; tile += gridDim.x) {
    int t = tile;
#define JOB(S, D, K_, N_, ND_, B_, M_)                                                               \
    { constexpr int cnt = (B_) * ((K_) / 64) * ((ND_) / 64);                                         \
      if (t >= 0 && t < cnt) do_transpose((S), (u16*)(ws + (D)), (K_), (N_), (ND_), (M_), t, smem);  \
      t -= cnt; }
    JOB(a.in[I_AWIN],   OFF_W_AIN,  1024, 2048, 2048, 2, 0)
    JOB(a.in[I_AWOUT],  OFF_W_AOUT, 1024, 1024, 1024, 2, 0)
    JOB(a.in[I_KVW],    OFF_W_KV,   1024, 1536, 1536, 1, 0)
    JOB(a.in[I_CMPW1],  OFF_W_C1,   2048, 256,  256,  2, 0)
    JOB(a.in[I_CMPW2],  OFF_W_C2,   256,  64,   128,  2, 0)
    JOB(a.in[I_BWIN],   OFF_W_BIN,  1024, 1072, 1152, 2, 0)
    JOB(a.in[I_BWOUT],  OFF_W_BOUT, 1024, 1024, 1024, 2, 0)
    JOB(a.in[I_FWIN],   OFF_W_FIN,  1024, 5632, 5632, 4, 1)
    JOB(a.in[I_FWOUT],  OFF_W_FOUT, 2816, 1024, 1024, 4, 0)
#undef JOB
  }
  const int tidp = otid();
  const int gt = blockIdx.x * NTHREADS + tidp, ng = gridDim.x * NTHREADS;
  for (int i = gt; i < 2048; i += ng) ((unsigned*)(ws + OFF_FLAG))[i] = 0u;
  {
    const float* gsrc = (const float*)(ws + OFF_HID);
    u16* gdst = (u16*)(ws + OFF_W_GATE);
    for (int i = gt; i < 2 * 2048 * 128; i += ng) {
      const int Lg = i >> 18, n = (i >> 7) & 2047, k = i & 127;
      const int hd = n >> 8, rp = n & 255, half = rp >> 7, q = (rp & 127) >> 6, rr = rp & 63, gate = rr >> 5;
      const int chl = half * 64 + q * 32 + (rr & 31);
      gdst[i] = f2bf(gsrc[((size_t)((Lg * 2 + gate) * 8 + hd) * 128 + k) * 128 + chl]);
    }
  }
  float* rope = (float*)(ws + OFF_ROPE);
  for (int i = gt; i < 2048 * 32; i += ng) {
    const int pos = i >> 5, fi = i & 31;
    const double freq = exp2(-(double)fi * (13.287712379549449 / 32.0));
    const double ang = (double)pos * freq;
    const double n = rint(ang * 0.15915494309189535);
    const float r = (float)(ang - n * 6.283185307179586);
    rope[2 * i] = cosf(r); rope[2 * i + 1] = sinf(r);
  }
  float* pb = (float*)(ws + OFF_PB);
  for (int it = blockIdx.x; it < 32; it += gridDim.x) {
    const int kv = it >> 4, ks = it & 15, n = tidp;
    const float* pos = a.in[I_CMPPOS] + kv * 2048 + ks * 128;
    const float* w1 = a.in[I_CMPW1] + ((size_t)kv * 2048 + ks * 128) * 256 + n;
    float s = 0.f;
    for (int k = 0; k < 128; ++k) s += pos[k] * w1[(size_t)k * 256];
    pb[(kv * 16 + ks) * 256 + n] = s;
  }
  u16* kcmp = (u16*)(ws + OFF_KCMP); u16* vcmpt = (u16*)(ws + OFF_VCMPT);
  for (int i = gt; i < 128 * 64; i += ng) {
    const int bg = i >> 6, d = i & 63;
    kcmp[((size_t)bg * 128 + 127) * 64 + d] = 0;
    vcmpt[((size_t)bg * 64 + d) * 128 + 127] = 0;
  }
}

__device__ __forceinline__ void conv_phase(const KArgs& a, int L) {
  const u16* ZR = (const u16*)(a.ws + OFF_BUFA) + (size_t)T_TOK * 1024;
  u16* XR = (u16*)(a.ws + OFF_U);
  const int gt = blockIdx.x * NTHREADS + otid(), ng = gridDim.x * NTHREADS;
  const int ch0 = (gt & 127) * 8;
  float cw[4][8], cb[8];
#pragma unroll
  for (int c = 0; c < 8; ++c) {
    cb[c] = a.in[I_ACONVB][(size_t)L * 1024 + ch0 + c];
#pragma unroll
    for (int k = 0; k < 4; ++k) cw[k][c] = a.in[I_ACONVW][(size_t)(L * 4 + k) * 1024 + ch0 + c];
  }
  for (int unit = gt; unit < (T_TOK / 16) * 128; unit += ng) {
    const int t0 = (unit >> 7) * 16, s0 = t0 & (SEQL - 1);
    const u16* src = ZR + (size_t)t0 * 1024 + ch0;
    uint4 rows[19];
#pragma unroll
    for (int r = 0; r < 19; ++r) {
      if (s0 + r - 3 >= 0) rows[r] = *(const uint4*)(src + (ptrdiff_t)(r - 3) * 1024);
      else rows[r] = make_uint4(0u, 0u, 0u, 0u);
    }
#pragma unroll
    for (int i = 0; i < 16; ++i) {
      float o[8];
#pragma unroll
      for (int c = 0; c < 8; ++c) o[c] = cb[c];
#pragma unroll
      for (int k = 0; k < 4; ++k) {
        const uint4 v = rows[i + k];
        const unsigned wv[4] = {v.x, v.y, v.z, v.w};
#pragma unroll
        for (int c = 0; c < 4; ++c) {
          o[2 * c] += cw[k][2 * c] * __uint_as_float(wv[c] << 16);
          o[2 * c + 1] += cw[k][2 * c + 1] * __uint_as_float(wv[c] & 0xffff0000u);
        }
      }
      uint4 pk; pk.x = pack2(o[0], o[1]); pk.y = pack2(o[2], o[3]); pk.z = pack2(o[4], o[5]); pk.w = pack2(o[6], o[7]);
      *(uint4*)(XR + (size_t)(t0 + i) * 1024 + ch0) = pk;
    }
  }
}

struct EpGate {
  static constexpr bool TR = false;
  const u16* xr; u16* la; u16* bv; const float* gb; const float* lam;
  __device__ __forceinline__ void operator()(f32x4 (&acc)[4][4], int mb, int nb, int lane) const {
    const int c16 = lane & 15, quad = lane >> 4;
    const int chb = (nb >> 8) * 128 + ((nb >> 7) & 1) * 64 + ((nb >> 6) & 1) * 32;
#pragma unroll
    for (int ni = 0; ni < 2; ++ni) {
      const int ch = chb + ni * 16 + c16;
      const float g0b = gb[ch], g1b = gb[1024 + ch];
      const float cl = -8.f * log1pf(expf(-lam[ch]));
#pragma unroll
      for (int mi = 0; mi < 4; ++mi)
#pragma unroll
        for (int j = 0; j < 4; ++j) {
          const size_t idx = (size_t)(mb + mi * 16 + quad * 4 + j) * 1024 + ch;
          const float r = 1.f / (1.f + __expf(-(acc[mi][ni][j] + g0b)));
          const float ig = 1.f / (1.f + __expf(-(acc[mi][ni + 2][j] + g1b)));
          const float l = cl * r;
          const float av = __expf(l);
          const float bt = sqrtf(fmaxf(1.f - av * av, 0.f)) * (ig * bf2f(xr[idx]));
          la[idx] = f2bf(l); bv[idx] = f2bf(bt);
        }
    }
  }
};

__device__ __forceinline__ void gates_phase(const KArgs& a, int L, char* smem) {
  char* ws = a.ws;
  const u16* XR = (const u16*)(ws + OFF_U);
  EpGate ep{XR, (u16*)(ws + OFF_BUFA) + (size_t)T_TOK * 1024, (u16*)(ws + OFF_KC), a.in[I_AGATEB] + (size_t)L * 2048, a.in[I_ALAM] + (size_t)L * 1024};
  const u16* Bt = (const u16*)(ws + OFF_W_GATE) + (size_t)L * 2048 * 128;
  const int iters = super_iters(512, 16, 4);
  for (int it = 0; it < iters; ++it) {
    int m, n;
    if (super_tile(it, 512, 16, 4, m, n)) {
      APlain ap{XR + (n >> 1) * 128, 1024};
      gemm_tile(ap, Bt, 128, m * 128, n * 128, ep, smem);
    }
  }
}

__device__ __forceinline__ void scan_phase(const KArgs& a, char* smem) {
  float* sP = (float*)smem; float* sH = sP + 256;
  const int tid = otid(), lane = tid & 63, w = tid >> 6;
  const u16* Y = (const u16*)(a.ws + OFF_BUFA);
  const u16* LA = Y + (size_t)T_TOK * 1024;
  const u16* BV = (const u16*)(a.ws + OFF_KC);
  u16* YH = (u16*)(a.ws + OFF_U);
  for (int item = blockIdx.x; item < 512; item += gridDim.x) {
    const int b = item >> 4, ch = (item & 15) * 64 + lane;
    const size_t base = ((size_t)b * SEQL + w * 512) * 1024 + ch;
    float P = 1.f, H = 0.f;
    for (int t = 0; t < 512; t += 16) {
      u16 l8[16], b8[16];
#pragma unroll
      for (int i = 0; i < 16; ++i) { l8[i] = LA[base + (size_t)(t + i) * 1024]; b8[i] = BV[base + (size_t)(t + i) * 1024]; }
#pragma unroll
      for (int i = 0; i < 16; ++i) { const float av = __expf(bf2f(l8[i])); H = av * H + bf2f(b8[i]); P *= av; }
    }
    __syncthreads();
    sP[w * 64 + lane] = P; sH[w * 64 + lane] = H;
    __syncthreads();
    float h = 0.f;
    for (int s2 = 0; s2 < w; ++s2) h = sP[s2 * 64 + lane] * h + sH[s2 * 64 + lane];
    for (int t = 0; t < 512; t += 16) {
      u16 l8[16], b8[16], y8[16];
#pragma unroll
      for (int i = 0; i < 16; ++i) { const size_t idx = base + (size_t)(t + i) * 1024; l8[i] = LA[idx]; b8[i] = BV[idx]; y8[i] = Y[idx]; }
#pragma unroll
      for (int i = 0; i < 16; ++i) {
        h = __expf(bf2f(l8[i])) * h + bf2f(b8[i]);
        YH[base + (size_t)(t + i) * 1024] = f2bf(bf2f(y8[i]) * h);
      }
    }
  }
}

#define SM_SHIFT 8.0f
__device__ __forceinline__ void qk_tile(const u16* Ks, const bf16x8 (&qf)[2][2], f32x4 (&S)[4][2], int c16, int quad) {
#pragma unroll
  for (int mb = 0; mb < 4; ++mb) {
#pragma unroll
    for (int nb = 0; nb < 2; ++nb) S[mb][nb] = f32x4{-SM_SHIFT, -SM_SHIFT, -SM_SHIFT, -SM_SHIFT};
#pragma unroll
    for (int ks = 0; ks < 2; ++ks) {
      const bf16x8 kf = *(const bf16x8*)(Ks + (mb * 16 + c16) * 72 + ks * 32 + quad * 8);
#pragma unroll
      for (int nb = 0; nb < 2; ++nb) S[mb][nb] = mfma16(kf, qf[nb][ks], S[mb][nb]);
    }
  }
}
__device__ __forceinline__ void pv_tile(const u16* Vs, int koff, const f32x4 (&P)[4][2], f32x4 (&O)[4][2], int c16, int quad) {
#pragma unroll
  for (int kk = 0; kk < 2; ++kk) {
    bf16x8 pf[2];
#pragma unroll
    for (int nb = 0; nb < 2; ++nb) {
      u32x4 t;
      t.x = pack2(P[2 * kk][nb][0], P[2 * kk][nb][1]); t.y = pack2(P[2 * kk][nb][2], P[2 * kk][nb][3]);
      t.z = pack2(P[2 * kk + 1][nb][0], P[2 * kk + 1][nb][1]); t.w = pack2(P[2 * kk + 1][nb][2], P[2 * kk + 1][nb][3]);
      pf[nb] = __builtin_bit_cast(bf16x8, t);
    }
#pragma unroll
    for (int db = 0; db < 4; ++db) {
      const u16* vp = Vs + (db * 16 + c16) * 136 + koff + kk * 32 + quad * 4;
      const uint2 lo = *(const uint2*)vp, hi = *(const uint2*)(vp + 16);
      u32x4 t; t.x = lo.x; t.y = lo.y; t.z = hi.x; t.w = hi.y;
      const bf16x8 vf = __builtin_bit_cast(bf16x8, t);
#pragma unroll
      for (int nb = 0; nb < 2; ++nb) O[db][nb] = mfma16(vf, pf[nb], O[db][nb]);
    }
  }
}

template <bool NOMASK, class MaskF>
__device__ __forceinline__ void flash_step(const u16* Ks, const u16* Vs, const bf16x8 (&qf)[2][2], f32x4 (&O)[4][2], float (&m)[2], float (&l)[2],
                                           const MaskF& valid, int c16, int quad) {
  f32x4 S[4][2];
  qk_tile(Ks, qf, S, c16, quad);
#pragma unroll
  for (int nb = 0; nb < 2; ++nb) {
    float rs = 0.f;
#pragma unroll
    for (int mb = 0; mb < 4; ++mb)
#pragma unroll
      for (int j = 0; j < 4; ++j) {
        const float pv = (NOMASK || valid(nb, mb * 16 + j)) ? __builtin_amdgcn_exp2f(S[mb][nb][j]) : 0.f;
        S[mb][nb][j] = pv; rs += pv;
      }
    rs += __shfl_xor(rs, 16); rs += __shfl_xor(rs, 32);
    l[nb] += rs;
  }
  pv_tile(Vs, 0, S, O, c16, quad);
}

__device__ __forceinline__ void attn_phase(const KArgs& a, char* smem) {
  u16* Ks = (u16*)smem;
  u16* Vs = (u16*)(smem + 18432);
  float* impM = (float*)(smem + 35840);
  float* impT = (float*)(smem + 35840 + 16896);
  float* sc = (float*)(smem + 69632);
  unsigned* selm = (unsigned*)(smem + 73856);
  unsigned* anyj = selm + 32;
  const u16* Q = (const u16*)(a.ws + OFF_BUFA);
  u16* Oo = (u16*)(a.ws + OFF_BUFA) + (size_t)T_TOK * 1024;
  const float* gates = (const float*)(a.ws + OFF_GATES);
  const u16* kcmp = (const u16*)(a.ws + OFF_KCMP); const u16* vcmpt = (const u16*)(a.ws + OFF_VCMPT);
  const u16* ksl = (const u16*)(a.ws + OFF_KS); const u16* kwn = (const u16*)(a.ws + OFF_KW);
  const u16* vst = (const u16*)(a.ws + OFF_VST); const u16* vwt = (const u16*)(a.ws + OFF_VWT);

  for (int item = blockIdx.x; item < 8192; item += gridDim.x) {
    const int tid = otid(), lane = tid & 63, w = tid >> 6, c16 = lane & 15, quad = lane >> 4;
    const int qt = 63 - (item >> 7), bg = item & 127, b = bg >> 2, g = bg & 3;
    const int s0 = qt * 32, hq = g * 4 + w;
    const size_t tok0 = (size_t)b * SEQL + s0;
    bf16x8 qf[2][2];
#pragma unroll
    for (int nb = 0; nb < 2; ++nb)
#pragma unroll
      for (int ks = 0; ks < 2; ++ks) qf[nb][ks] = *(const bf16x8*)(Q + (tok0 + nb * 16 + c16) * 1024 + hq * 64 + ks * 32 + quad * 8);
    int tq[2]; tq[0] = s0 + c16; tq[1] = s0 + 16 + c16;
    f32x4 of[4][2];
#pragma unroll
    for (int db = 0; db < 4; ++db)
#pragma unroll
      for (int nb = 0; nb < 2; ++nb) of[db][nb] = f32x4{0.f, 0.f, 0.f, 0.f};

    __syncthreads();
    {
      const u16* kc = kcmp + (size_t)bg * 128 * 64;
      const u16* vc = vcmpt + (size_t)bg * 64 * 128;
#pragma unroll
      for (int i = 0; i < 4; ++i) {
        const int id = tid + i * 256;
        { const int r = id >> 3, c = id & 7; *(uint4*)(Ks + r * 72 + c * 8) = *(const uint4*)(kc + r * 64 + c * 8); }
        { const int r = id >> 4, c = id & 15; *(uint4*)(Vs + r * 136 + c * 8) = *(const uint4*)(vc + r * 128 + c * 8); }
      }
      if (tid < 32) selm[tid] = 0u;
      if (tid == 32) *anyj = 0u;
    }
    __syncthreads();
    {
      int cmax[2]; cmax[0] = ((tq[0] - 31) >> 4) - quad * 4; cmax[1] = ((tq[1] - 31) >> 4) - quad * 4;
      float lC[2] = {0.f, 0.f};
#pragma unroll
      for (int h = 0; h < 2; ++h) {
        f32x4 S[4][2];
        qk_tile(Ks + h * 64 * 72, qf, S, c16, quad);
#pragma unroll
        for (int nb = 0; nb < 2; ++nb) {
          float rs = 0.f;
#pragma unroll
          for (int mb = 0; mb < 4; ++mb)
#pragma unroll
            for (int j = 0; j < 4; ++j) rs += (h * 64 + mb * 16 + j <= cmax[nb]) ? __builtin_amdgcn_exp2f(S[mb][nb][j]) : 0.f;
          rs += __shfl_xor(rs, 16); rs += __shfl_xor(rs, 32);
          lC[nb] += rs;
        }
      }
      float invC[2]; invC[0] = (lC[0] > 0.f) ? 1.f / lC[0] : 0.f; invC[1] = (lC[1] > 0.f) ? 1.f / lC[1] : 0.f;
      f32x4 Oc[4][2];
#pragma unroll
      for (int db = 0; db < 4; ++db)
#pragma unroll
        for (int nb = 0; nb < 2; ++nb) Oc[db][nb] = f32x4{0.f, 0.f, 0.f, 0.f};
#pragma unroll
      for (int h = 0; h < 2; ++h) {
        f32x4 S[4][2];
        qk_tile(Ks + h * 64 * 72, qf, S, c16, quad);
#pragma unroll
        for (int nb = 0; nb < 2; ++nb)
#pragma unroll
          for (int mb = 0; mb < 4; ++mb) {
#pragma unroll
            for (int j = 0; j < 4; ++j)
              S[mb][nb][j] = (h * 64 + mb * 16 + j <= cmax[nb]) ? __builtin_amdgcn_exp2f(S[mb][nb][j]) * invC[nb] : 0.f;
            const int jb = h * 16 + mb * 4 + quad;
            const int idx = (w * 32 + nb * 16 + c16) * 33 + jb;
            impM[idx] = S[mb][nb][0] + S[mb][nb][1] + S[mb][nb][2] + 0.5f * S[mb][nb][3];
            impT[idx] = 0.5f * S[mb][nb][3];
          }
        pv_tile(Vs, h * 64, S, Oc, c16, quad);
      }
#pragma unroll
      for (int nb = 0; nb < 2; ++nb) {
        const float gc = gates[(tok0 + nb * 16 + c16) * 48 + hq];
#pragma unroll
        for (int db = 0; db < 4; ++db) of[db][nb] += Oc[db][nb] * gc;
      }
      __syncthreads();
      {
        const int qq = tid & 31, jg = tid >> 5;
        const int cur = (s0 + qq) >> 6;
#pragma unroll
        for (int k = 0; k < 4; ++k) {
          const int j = jg * 4 + k;
          float imp = 0.f;
#pragma unroll
          for (int ww = 0; ww < 4; ++ww) {
            imp += impM[(ww * 32 + qq) * 33 + j];
            if (j > 0) imp += impT[(ww * 32 + qq) * 33 + j - 1];
          }
          float s = imp;
          if (j > cur) s = -1e30f; else if (j == 0 || cur - j < 2) s = 1e30f;
          sc[qq * 33 + j] = s;
        }
        __syncthreads();
        unsigned bits = 0u;
#pragma unroll
        for (int k = 0; k < 4; ++k) {
          const int j = jg * 4 + k;
          const float sj = sc[qq * 33 + j];
          int cnt = 0;
          for (int i = 0; i < 32; ++i) { const float si = sc[qq * 33 + i]; cnt += (si > sj || (si == sj && i < j)) ? 1 : 0; }
          if (cnt < 16) bits |= 1u << j;
        }
        atomicOr(&selm[qq], bits);
        atomicOr(anyj, bits);
      }
    }
    __syncthreads();
    unsigned sel[2]; sel[0] = selm[c16]; sel[1] = selm[16 + c16];
    const unsigned anym = *anyj;

    {
      f32x4 O2[4][2]; float m[2] = {-1e30f, -1e30f}, l[2] = {0.f, 0.f};
#pragma unroll
      for (int db = 0; db < 4; ++db)
#pragma unroll
        for (int nb = 0; nb < 2; ++nb) O2[db][nb] = f32x4{0.f, 0.f, 0.f, 0.f};
      const int jmax = (s0 + 31) >> 6;
      unsigned rem = anym & ((2u << jmax) - 1u);
      const int r0 = tid >> 3, c0 = tid & 7;
      const u16* kbase = ksl + (size_t)bg * SEQL * 64 + r0 * 64 + c0 * 8;
      const u16* vbase = vst + (size_t)bg * 64 * SEQL + (size_t)r0 * SEQL + c0 * 8;
      uint4 rk0, rk1, rv0, rv1;
      int j = __ffs(rem) - 1;
      rk0 = *(const uint4*)(kbase + (size_t)j * 64 * 64); rk1 = *(const uint4*)(kbase + (size_t)j * 64 * 64 + 32 * 64);
      rv0 = *(const uint4*)(vbase + j * 64); rv1 = *(const uint4*)(vbase + j * 64 + (size_t)32 * SEQL);
      for (;;) {
        rem &= rem - 1u;
        __syncthreads();
        *(uint4*)(Ks + r0 * 72 + c0 * 8) = rk0; *(uint4*)(Ks + (r0 + 32) * 72 + c0 * 8) = rk1;
        *(uint4*)(Vs + r0 * 136 + c0 * 8) = rv0; *(uint4*)(Vs + (r0 + 32) * 136 + c0 * 8) = rv1;
        __syncthreads();
        const int jn = rem ? (__ffs(rem) - 1) : -1;
        if (jn >= 0) {
          rk0 = *(const uint4*)(kbase + (size_t)jn * 64 * 64); rk1 = *(const uint4*)(kbase + (size_t)jn * 64 * 64 + 32 * 64);
          rv0 = *(const uint4*)(vbase + jn * 64); rv1 = *(const uint4*)(vbase + jn * 64 + (size_t)32 * SEQL);
        }
        int lim[2];
        lim[0] = ((sel[0] >> j) & 1u) ? (tq[0] - j * 64 - quad * 4) : -1;
        lim[1] = ((sel[1] >> j) & 1u) ? (tq[1] - j * 64 - quad * 4) : -1;
        auto valid = [&](int nb, int kk) -> bool { return kk <= lim[nb]; };
        const bool full = (j * 64 + 63 <= s0) && __all((int)(((sel[0] >> j) & (sel[1] >> j)) & 1u));
        if (full) flash_step<true>(Ks, Vs, qf, O2, m, l, valid, c16, quad);
        else flash_step<false>(Ks, Vs, qf, O2, m, l, valid, c16, quad);
        if (jn < 0) break;
        j = jn;
      }
#pragma unroll
      for (int nb = 0; nb < 2; ++nb) {
        const float gs = gates[(tok0 + nb * 16 + c16) * 48 + 16 + hq] * ((l[nb] > 0.f) ? 1.f / l[nb] : 0.f);
#pragma unroll
        for (int db = 0; db < 4; ++db) of[db][nb] += O2[db][nb] * gs;
      }
    }
    {
      f32x4 O3[4][2]; float m[2] = {-1e30f, -1e30f}, l[2] = {0.f, 0.f};
#pragma unroll
      for (int db = 0; db < 4; ++db)
#pragma unroll
        for (int nb = 0; nb < 2; ++nb) O3[db][nb] = f32x4{0.f, 0.f, 0.f, 0.f};
      const int jlo = (s0 >= 511) ? ((s0 - 511) >> 6) : 0, jhi = (s0 + 31) >> 6;
      const int r0 = tid >> 3, c0 = tid & 7;
      const u16* kbase = kwn + (size_t)bg * SEQL * 64 + r0 * 64 + c0 * 8;
      const u16* vbase = vwt + (size_t)bg * 64 * SEQL + (size_t)r0 * SEQL + c0 * 8;
      uint4 rk0, rk1, rv0, rv1;
      rk0 = *(const uint4*)(kbase + (size_t)jlo * 64 * 64); rk1 = *(const uint4*)(kbase + (size_t)jlo * 64 * 64 + 32 * 64);
      rv0 = *(const uint4*)(vbase + jlo * 64); rv1 = *(const uint4*)(vbase + jlo * 64 + (size_t)32 * SEQL);
      for (int j = jlo; j <= jhi; ++j) {
        __syncthreads();
        *(uint4*)(Ks + r0 * 72 + c0 * 8) = rk0; *(uint4*)(Ks + (r0 + 32) * 72 + c0 * 8) = rk1;
        *(uint4*)(Vs + r0 * 136 + c0 * 8) = rv0; *(uint4*)(Vs + (r0 + 32) * 136 + c0 * 8) = rv1;
        __syncthreads();
        if (j < jhi) {
          const int jn = j + 1;
          rk0 = *(const uint4*)(kbase + (size_t)jn * 64 * 64); rk1 = *(const uint4*)(kbase + (size_t)jn * 64 * 64 + 32 * 64);
          rv0 = *(const uint4*)(vbase + jn * 64); rv1 = *(const uint4*)(vbase + jn * 64 + (size_t)32 * SEQL);
        }
        int lim[2]; lim[0] = tq[0] - j * 64 - quad * 4; lim[1] = tq[1] - j * 64 - quad * 4;
        auto valid = [&](int nb, int kk) -> bool { return (kk <= lim[nb]) && (kk > lim[nb] - 512); };
        const bool full = (j * 64 + 63 <= s0) && (j * 64 > s0 + 31 - 512);
        if (full) flash_step<true>(Ks, Vs, qf, O3, m, l, valid, c16, quad);
        else flash_step<false>(Ks, Vs, qf, O3, m, l, valid, c16, quad);
      }
#pragma unroll
      for (int nb = 0; nb < 2; ++nb) {
        const float gs = gates[(tok0 + nb * 16 + c16) * 48 + 32 + hq] * ((l[nb] > 0.f) ? 1.f / l[nb] : 0.f);
#pragma unroll
        for (int db = 0; db < 4; ++db) of[db][nb] += O3[db][nb] * gs;
      }
    }
#pragma unroll
    for (int nb = 0; nb < 2; ++nb)
#pragma unroll
      for (int db = 0; db < 4; ++db) {
        uint2 pk; pk.x = pack2(of[db][nb][0], of[db][nb][1]); pk.y = pack2(of[db][nb][2], of[db][nb][3]);
        *(uint2*)(Oo + (tok0 + nb * 16 + c16) * 1024 + hq * 64 + db * 16 + quad * 4) = pk;
      }
  }
}

__device__ __forceinline__ bool dbg_bad(float got, float ref) { return !(fabsf(got - ref) <= 0.03f + 0.04f * fabsf(ref)); }
__device__ __forceinline__ void check_ain(const KArgs& a) {
  const int gt = blockIdx.x * NTHREADS + otid();
  if (gt >= 65536) return;
  const unsigned s = (unsigned)gt;
  const int row = (int)(s & 31u) * 2048, col = (int)(s >> 5);
  const int b = row >> 11, ch = col & 1023;
  const u16* u = (const u16*)(a.ws + OFF_U) + (size_t)row * 1024;
  const float* w = a.in[I_AWIN] + col;
  float acc = 0.f;
  for (int k = 0; k < 1024; ++k) acc += bf2f(u[k]) * w[(size_t)k * 2048];
  const u16* Y = (const u16*)(a.ws + OFF_BUFA);
  float got, ref;
  if (col < 1024) { got = bf2f(Y[(size_t)row * 1024 + col]); ref = gelu_tanh(acc); }
  else { got = bf2f(Y[(size_t)T_TOK * 1024 + (size_t)row * 1024 + col - 1024]); ref = acc; }
  if (dbg_bad(got, ref)) { atomicAdd((unsigned*)(a.ws + OFF_FLAG), 1u); ((unsigned*)(a.ws + OFF_FLAG))[16 + ch] = 1u; ((unsigned*)(a.ws + OFF_FLAG))[1100 + b] = 1u; }

}
__device__ __forceinline__ void check_scan(const KArgs& a) {
  const int gt = blockIdx.x * NTHREADS + otid();
  if (gt >= 32768) return;
  const unsigned s = (unsigned)gt;
  const int b = (int)(s & 31u), ch = (int)(s >> 5), hd = ch >> 7;
  const u16* Y = (const u16*)(a.ws + OFF_BUFA);
  const u16* ZR = Y + (size_t)T_TOK * 1024;
  const float* gw = (const float*)(a.ws + OFF_HID);
  const float lam = a.in[I_ALAM][ch];
  const float cl = -8.f * log1pf(expf(-lam));
  float h = 0.f;
  bool bad = false;
  for (int t = 0; t < 1; ++t) {
    float g0 = a.in[I_AGATEB][ch], g1 = a.in[I_AGATEB][1024 + ch], xme = 0.f;
    for (int i = 0; i < 128; ++i) {
      const int ci = hd * 128 + i;
      float xr = a.in[I_ACONVB][ci];
      for (int k = 0; k < 4; ++k) { const int tt = t - 3 + k; if (tt >= 0) xr += a.in[I_ACONVW][k * 1024 + ci] * bf2f(ZR[((size_t)b * SEQL + tt) * 1024 + ci]); }
      g0 += xr * gw[((size_t)(0 * 8 + hd) * 128 + i) * 128 + (ch & 127)];
      g1 += xr * gw[((size_t)(1 * 8 + hd) * 128 + i) * 128 + (ch & 127)];
      if (ci == ch) xme = xr;
    }
    const float r = 1.f / (1.f + expf(-g0)), ig = 1.f / (1.f + expf(-g1));
    const float la = cl * r, av = expf(la), bt = sqrtf(fmaxf(-expm1f(2.f * la), 0.f)) * ig * xme;
    h = av * h + bt;
    const u16* u = (const u16*)(a.ws + OFF_U) + ((size_t)b * SEQL + t) * 1024;
    float acc = 0.f;
    for (int k = 0; k < 1024; ++k) acc += bf2f(u[k]) * a.in[I_AWIN][(size_t)k * 2048 + ch];
    const float ref = gelu_tanh(acc) * h;
    const float got = bf2f(Y[((size_t)b * SEQL + t) * 1024 + ch]);
    if (t == 0 && dbg_bad(got, ref)) { atomicAdd((unsigned*)(a.ws + OFF_FLAG), 1u); ((unsigned*)(a.ws + OFF_FLAG))[16 + ch] = 1u; ((unsigned*)(a.ws + OFF_FLAG))[1100 + b] = 1u; }
  }
}
__device__ __forceinline__ void check_ffn1(const KArgs& a) {
  const int gt = blockIdx.x * NTHREADS + otid();
  if (gt >= 8192) return;
  const unsigned s = (unsigned)gt;
  const int row = (int)((s * 2654435761u) >> 16), hid = (int)((s * 40503u + 17u) % 2816u);
  const u16* u = (const u16*)(a.ws + OFF_U) + (size_t)row * 1024;
  const float* w = a.in[I_FWIN];
  float g = 0.f, up = 0.f;
  for (int k = 0; k < 1024; ++k) { const float uv = bf2f(u[k]); g += uv * w[(size_t)k * 5632 + hid]; up += uv * w[(size_t)k * 5632 + 2816 + hid]; }
  const float ref = g / (1.f + expf(-g)) * up;
  const float got = bf2f(((const u16*)(a.ws + OFF_BUFA))[(size_t)row * FHID + hid]);

}
__device__ __forceinline__ void check_ffn2(const KArgs& a, const float* hold) {
}

#define N_PHASES 37
#define BISECT_HI N_PHASES

__global__ void __launch_bounds__(NTHREADS, 2) yoco_mega(KArgs a) {
  extern __shared__ __attribute__((aligned(16))) char smem[];
  cg::grid_group grid = cg::this_grid();
  char* ws = a.ws;
  volatile LDS_AS unsigned* xbst = (volatile LDS_AS unsigned*)(smem + SMEM_BYTES - 16);
  if (threadIdx.x == 0) { xbst[0] = 0u; xbst[1] = 0u; }
  __syncthreads();
  const XcdBarrier xb = xcd_barrier_post((unsigned*)(ws + OFF_BAR), xbst);
  const float* rope = (const float*)(ws + OFF_ROPE);
  int ph = 0;
#define GRID_BARRIER() { asm volatile("s_waitcnt vmcnt(0)" ::: "memory"); __builtin_amdgcn_fence(__ATOMIC_RELEASE, "agent"); asm volatile("s_waitcnt vmcnt(0)" ::: "memory"); \
    grid.sync(); __builtin_amdgcn_fence(__ATOMIC_ACQUIRE, "agent"); asm volatile("s_waitcnt vmcnt(0)" ::: "memory"); }
#define PHASE(...) { if (ph >= a.lo && ph < a.hi) { __VA_ARGS__; if (ph + 1 < a.hi) { if (a.lo < 0) { GRID_BARRIER(); } else xcd_barrier(xb); } } ++ph; }
  PHASE(prep_phase(a, smem))
  for (int layer = 0; layer < 4; ++layer) {
    if (layer < 2) {
      const int L = layer;
      const float* hin = (L == 0) ? a.in[I_X] : a.out;
      PHASE(norm_phase(hin, a.in[I_ANORM] + (size_t)L * 1024, (u16*)(ws + OFF_U)))
      PHASE({
        APlain ap{(const u16*)(ws + OFF_U), 1024};
        EpAin ep{(u16*)(ws + OFF_BUFA), (u16*)(ws + OFF_BUFA) + (size_t)T_TOK * 1024};
        gemm_phase(ap, (const u16*)(ws + OFF_W_AIN) + (size_t)L * 2048 * 1024, 1024, 512, 16, ep, smem, 4);
      })
      PHASE(conv_phase(a, L))
      PHASE(gates_phase(a, L, smem))
      PHASE(scan_phase(a, smem))
      PHASE({
        APlain ap{(const u16*)(ws + OFF_U), 1024};
        EpRes ep{hin, a.out, ABL_A};
        gemm_phase(ap, (const u16*)(ws + OFF_W_AOUT) + (size_t)L * 1024 * 1024, 1024, 512, 8, ep, smem, 8);
      })
    } else {
      const int Lb = layer - 2;
      if (Lb == 0) {
        PHASE(norm_phase(a.out, a.in[I_KVNORM], (u16*)(ws + OFF_U)))
        PHASE({
          APlain ap{(const u16*)(ws + OFF_U), 1024};
          EpKV ep{ws, a.in[I_KNORM], rope};
          gemm_phase(ap, (const u16*)(ws + OFF_W_KV), 1024, 512, 12, ep, smem, 4);
        })
        PHASE({
          for (int kv = 0; kv < 2; ++kv) {
            ACmp ap{(const u16*)(ws + (kv == 0 ? OFF_KC : OFF_VC))};
            EpCmp1 ep{(u16*)(ws + OFF_HID) + (size_t)kv * 16256 * 256, (const float*)(ws + OFF_PB) + kv * 16 * 256, a.in[I_CMPB1] + kv * 256};
            gemm_phase(ap, (const u16*)(ws + OFF_W_C1) + (size_t)kv * 256 * 2048, 2048, 127, 2, ep, smem, 2);
          }
        })
        PHASE({
          for (int kv = 0; kv < 2; ++kv) {
            APlain ap{(const u16*)(ws + OFF_HID) + (size_t)kv * 16256 * 256, 256};
            EpCmp2 ep{ws, kv, a.in[I_CMPB2] + kv * 64, a.in[I_KNORM], rope};
            gemm_phase(ap, (const u16*)(ws + OFF_W_C2) + (size_t)kv * 128 * 256, 256, 127, 1, ep, smem, 1);
          }
        })
      }
      PHASE(norm_phase(a.out, a.in[I_BNORM] + (size_t)Lb * 1024, (u16*)(ws + OFF_U)))
      PHASE({
        APlain ap{(const u16*)(ws + OFF_U), 1024};
        EpQ ep{(u16*)(ws + OFF_BUFA), (float*)(ws + OFF_GATES), a.in[I_QNORM] + Lb * 64, a.in[I_BGATEB] + Lb * 48, rope};
        gemm_phase(ap, (const u16*)(ws + OFF_W_BIN) + (size_t)Lb * 1152 * 1024, 1024, 512, 9, ep, smem, 3);
      })
      PHASE(attn_phase(a, smem))
      PHASE({
        APlain ap{(const u16*)(ws + OFF_BUFA) + (size_t)T_TOK * 1024, 1024};
        EpRes ep{a.out, a.out, ABL_B};
        gemm_phase(ap, (const u16*)(ws + OFF_W_BOUT) + (size_t)Lb * 1024 * 1024, 1024, 512, 8, ep, smem, 8);
      })
    }
    PHASE(norm_phase(a.out, a.in[I_FNORM] + (size_t)layer * 1024, (u16*)(ws + OFF_U)))
    PHASE({
      APlain ap{(const u16*)(ws + OFF_U), 1024};
      EpFfn1 ep{(u16*)(ws + OFF_BUFA)};
      gemm_phase(ap, (const u16*)(ws + OFF_W_FIN) + (size_t)layer * 5632 * 1024, 1024, 512, 44, ep, smem, 4);
    })
    PHASE({
      APlain ap{(const u16*)(ws + OFF_BUFA), FHID};
      EpRes ep{a.out, a.out, ABL_F};
      gemm_phase(ap, (const u16*)(ws + OFF_W_FOUT) + (size_t)layer * 1024 * FHID, FHID, 512, 8, ep, smem, 8);
    })
  }
#undef PHASE
}

extern "C" void kernel_launch(void* const* d_in, const int* in_sizes, int n_in, void* d_out, int out_size, void* d_ws, size_t ws_size,
                              hipStream_t stream) {
  static int grid_blocks = 0;
  if (!grid_blocks) {
    int dev = 0, cus = 0, per_cu = 0;
    hipGetDevice(&dev);
    hipDeviceGetAttribute(&cus, hipDeviceAttributeMultiprocessorCount, dev);
    if (hipFuncSetAttribute((const void*)yoco_mega, hipFuncAttributeMaxDynamicSharedMemorySize, SMEM_BYTES) != hipSuccess) fprintf(stderr, "hipFuncSetAttribute failed\n");
    hipOccupancyMaxActiveBlocksPerMultiprocessor(&per_cu, (const void*)yoco_mega, NTHREADS, SMEM_BYTES);
    if (per_cu < 1) per_cu = 1;
    if (per_cu > 2) per_cu = 2;
    grid_blocks = cus * per_cu;
  }
  if (ws_size < WS_END) { fprintf(stderr, "ws too small: %zu < %zu\n", ws_size, (size_t)WS_END); return; }
  { static const int exp_sizes[25] = {65536*1024, 2*1024, 2*1024*2048, 2*4*1024, 2*1024, 2*2*8*128*128, 2*2*1024, 2*1024, 2*1024*1024, 1024, 1024*1536, 3*64, 2*32*64, 2*2048*256, 2*256, 2*256*64, 2*64, 2*1024, 2*1024*1072, 2*48, 2*64, 2*1024*1024, 4*1024, 4*1024*5632, 4*2816*1024};
    if (n_in != 25) return;
    for (int i = 0; i < 25; ++i) if (in_sizes[i] != exp_sizes[i]) { fprintf(stderr, "in_sizes[%d] = %d, expected %d\n", i, in_sizes[i], exp_sizes[i]); return; } }
  KArgs a{};
  for (int i = 0; i < 25; ++i) a.in[i] = (const float*)d_in[i];
  a.out = (float*)d_out;
  a.ws = (char*)d_ws;
  hipMemsetAsync((char*)d_ws + OFF_BAR, 0, XCD_BAR_BYTES, stream);
  hipMemcpyAsync((char*)d_ws + OFF_HID, d_in[5], (size_t)in_sizes[5] * 4, hipMemcpyDeviceToDevice, stream);
#ifdef MULTI_LAUNCH
  for (int ph = 0; ph < N_PHASES; ++ph) {
    a.lo = ph; a.hi = ph + 1;
    hipLaunchKernelGGL(yoco_mega, dim3(grid_blocks), dim3(NTHREADS), SMEM_BYTES, stream, a);
  }
#else
  a.lo = 0; a.hi = BISECT_HI;
  void* args[] = {&a};
  hipError_t e = hipLaunchCooperativeKernel((void*)yoco_mega, dim3(grid_blocks), dim3(NTHREADS), args, SMEM_BYTES, stream);
  if (e != hipSuccess) fprintf(stderr, "cooperative launch failed: %s (grid %d)\n", hipGetErrorString(e), grid_blocks);
#endif
}
```

```cpp
#include <hip/hip_runtime.h>
#include <hip/hip_cooperative_groups.h>
#include <cstdio>
#include <cstdint>
namespace cg = cooperative_groups;

typedef unsigned short u16;
typedef short bf16x8 __attribute__((ext_vector_type(8)));
typedef float f32x4 __attribute__((ext_vector_type(4)));
typedef unsigned u32x4 __attribute__((ext_vector_type(4)));

#define T_TOK 65536
#define SEQL 2048
#define FHID 2816
#define NTHREADS 256
#define XCD_BAR_BYTES 16384
#define SMEM_BYTES 74240
#ifndef ABL_A
#define ABL_A 1.f
#endif
#ifndef ABL_B
#define ABL_B 1.f
#endif
#ifndef ABL_F
#define ABL_F 1.f
#endif
#define PREP_TILES (1024 + 512 + 384 + 256 + 16 + 576 + 512 + 5632 + 2816)

constexpr size_t OFF_W_AIN  = 0;
constexpr size_t OFF_W_GATE = OFF_W_AIN  + (size_t)2 * 2048 * 1024 * 2;
constexpr size_t OFF_W_AOUT = OFF_W_GATE + (size_t)64 * 128 * 128 * 2;
constexpr size_t OFF_W_KV   = OFF_W_AOUT + (size_t)2 * 1024 * 1024 * 2;
constexpr size_t OFF_W_C1   = OFF_W_KV   + (size_t)1536 * 1024 * 2;
constexpr size_t OFF_W_C2   = OFF_W_C1   + (size_t)2 * 256 * 2048 * 2;
constexpr size_t OFF_W_BIN  = OFF_W_C2   + (size_t)2 * 128 * 256 * 2;
constexpr size_t OFF_W_BOUT = OFF_W_BIN  + (size_t)2 * 1152 * 1024 * 2;
constexpr size_t OFF_W_FIN  = OFF_W_BOUT + (size_t)2 * 1024 * 1024 * 2;
constexpr size_t OFF_W_FOUT = OFF_W_FIN  + (size_t)4 * 5632 * 1024 * 2;
constexpr size_t OFF_ROPE   = OFF_W_FOUT + (size_t)4 * 1024 * 2816 * 2;
constexpr size_t OFF_PB     = OFF_ROPE   + (size_t)2048 * 32 * 2 * 4;
constexpr size_t OFF_U      = OFF_PB     + (size_t)2 * 16 * 256 * 4;
constexpr size_t OFF_BUFA   = OFF_U      + (size_t)T_TOK * 1024 * 2;
constexpr size_t OFF_KC     = OFF_BUFA   + (size_t)T_TOK * FHID * 2;
constexpr size_t OFF_VC     = OFF_KC     + (size_t)T_TOK * 256 * 2;
constexpr size_t OFF_KS     = OFF_VC     + (size_t)T_TOK * 256 * 2;
constexpr size_t OFF_KW     = OFF_KS     + (size_t)T_TOK * 256 * 2;
constexpr size_t OFF_VST    = OFF_KW     + (size_t)T_TOK * 256 * 2;
constexpr size_t OFF_VWT    = OFF_VST    + (size_t)T_TOK * 256 * 2;
constexpr size_t OFF_KCMP   = OFF_VWT    + (size_t)T_TOK * 256 * 2;
constexpr size_t OFF_VCMPT  = OFF_KCMP   + (size_t)128 * 128 * 64 * 2;
constexpr size_t OFF_HID    = OFF_VCMPT  + (size_t)128 * 64 * 128 * 2;
constexpr size_t OFF_GATES  = OFF_HID    + (size_t)2 * 16256 * 256 * 2;
#define OFF_FLAG (OFF_GATES + (size_t)T_TOK * 48 * 4)
#define OFF_BAR (OFF_FLAG + 16384)
constexpr size_t WS_END     = OFF_GATES  + (size_t)T_TOK * 48 * 4 + 16384 + XCD_BAR_BYTES;

struct KArgs {
  const float* in[25];
  float* out;
  char* ws;
  int lo, hi;
};
enum { I_X = 0, I_ANORM, I_AWIN, I_ACONVW, I_ACONVB, I_AGATEW, I_AGATEB, I_ALAM, I_AWOUT, I_KVNORM, I_KVW, I_KNORM,
       I_CMPPOS, I_CMPW1, I_CMPB1, I_CMPW2, I_CMPB2, I_BNORM, I_BWIN, I_BGATEB, I_QNORM, I_BWOUT, I_FNORM, I_FWIN, I_FWOUT };

__device__ __forceinline__ unsigned pack2(float lo, float hi) { unsigned r; asm("v_cvt_pk_bf16_f32 %0, %1, %2" : "=v"(r) : "v"(lo), "v"(hi)); return r; }
__device__ __forceinline__ u16 f2bf(float f) { return (u16)pack2(f, f); }
__device__ __forceinline__ float bf2f(u16 h) { return __uint_as_float(((unsigned)h) << 16); }
__device__ __forceinline__ float sigmoidf_(float x) { return 1.f / (1.f + __expf(-x)); }
__device__ __forceinline__ float gelu_tanh(float x) { float u = 0.7978845608028654f * (x + 0.044715f * x * x * x); return x / (1.f + __expf(-2.f * u)); }
__device__ __forceinline__ f32x4 mfma16(bf16x8 a, bf16x8 b, f32x4 c) { return __builtin_amdgcn_mfma_f32_16x16x32_bf16(a, b, c, 0, 0, 0); }

__device__ __forceinline__ int otid() { int t = threadIdx.x; asm volatile("" : "+v"(t)); return t; }

#define LDS_AS __attribute__((address_space(3)))
struct APlain {
  const u16* A; int lda;
  __device__ __forceinline__ const u16* rowptr(int row) const { return A + (size_t)row * lda; }
  __device__ __forceinline__ int kstride() const { return 64; }
};
struct ACmp {
  const u16* kc;
  __device__ __forceinline__ const u16* rowptr(int row) const {
    const int g = row & 3, bc = row >> 2, b = bc / 127, c = bc - b * 127;
    return kc + ((size_t)(b * SEQL + c * 16) * 256 + g * 64);
  }
  __device__ __forceinline__ int kstride() const { return 256; }
};

template <class AP, class EP>
__device__ __forceinline__ void gemm_tile(const AP& ap, const u16* __restrict__ Bt, int K, int m0, int n0, const EP& ep, char* smem) {
  const int tid = otid(), lane = tid & 63, w = tid >> 6, wm = w >> 1, wn = w & 1, c16 = lane & 15, quad = lane >> 4;
  const int nk = K >> 6;
  const int srow = lane >> 2;
  const int scol = (w & 1) * 32 + ((((lane & 3) * 16) ^ ((lane >> 5) << 5)) >> 1);
  const u16* ga[4]; const u16* gb[4];
#pragma unroll
  for (int p = 0; p < 4; ++p) {
    const int R = ((w >> 1) + 2 * p) * 16 + srow;
    ga[p] = ap.rowptr(m0 + R) + scol;
    gb[p] = Bt + (size_t)(n0 + R) * K + scol;
  }
  const int kstr = ap.kstride();
  const int lofs = (c16 * 64 + quad * 16) ^ ((c16 >> 3) << 5);
  f32x4 acc[4][4];
#pragma unroll
  for (int i = 0; i < 4; ++i)
#pragma unroll
    for (int j = 0; j < 4; ++j) acc[i][j] = f32x4{0.f, 0.f, 0.f, 0.f};

#define GSTAGE(buf_, kt_)                                                                                                        \
  _Pragma("unroll") for (int p = 0; p < 4; ++p) {                                                                                \
    __builtin_amdgcn_global_load_lds((const unsigned*)(ga[p] + (size_t)(kt_) * kstr),                                            \
                                     (LDS_AS unsigned*)(smem + (buf_) * 32768 + w * 1024 + p * 4096), 16, 0, 0);                 \
    __builtin_amdgcn_global_load_lds((const unsigned*)(gb[p] + (size_t)(kt_) * 64),                                              \
                                     (LDS_AS unsigned*)(smem + (buf_) * 32768 + 16384 + w * 1024 + p * 4096), 16, 0, 0);         \
  }
  GSTAGE(0, 0);
  asm volatile("s_waitcnt vmcnt(0)" ::: "memory");
  __syncthreads();
  for (int kt = 0; kt < nk; ++kt) {
    const int cur = kt & 1;
    if (kt + 1 < nk) { GSTAGE(cur ^ 1, kt + 1); }
    const char* pa = smem + cur * 32768 + (wm * 8) * 1024 + lofs;
    const char* pb = smem + cur * 32768 + 16384 + (wn * 8) * 1024 + lofs;
#pragma unroll
    for (int ks = 0; ks < 2; ++ks) {
      bf16x8 af[4], bfr[4];
#pragma unroll
      for (int i = 0; i < 4; ++i) { af[i] = *(const bf16x8*)(pa + (i * 2 + ks) * 1024); bfr[i] = *(const bf16x8*)(pb + (i * 2 + ks) * 1024); }
      __builtin_amdgcn_s_setprio(1);
#pragma unroll
      for (int i = 0; i < 4; ++i)
#pragma unroll
        for (int j = 0; j < 4; ++j) acc[i][j] = EP::TR ? mfma16(bfr[j], af[i], acc[i][j]) : mfma16(af[i], bfr[j], acc[i][j]);
      __builtin_amdgcn_s_setprio(0);
    }
    __builtin_amdgcn_sched_barrier(0);
    asm volatile("s_waitcnt vmcnt(0)" ::: "memory");
    __syncthreads();
  }
#undef GSTAGE
  ep(acc, m0 + wm * 64, n0 + wn * 64, lane);
}

__device__ __forceinline__ bool super_tile(int it, int mtiles, int ntiles, int SN, int& m, int& n) {
  const int nbx = gridDim.x >> 3, x = blockIdx.x & 7, lb = blockIdx.x >> 3;
  const int SM = nbx / SN, scols = (ntiles + SN - 1) / SN;
  const int s = x + 8 * it, sr = s / scols, sc = s - sr * scols;
  m = sr * SM + (lb % SM); n = sc * SN + (lb / SM);
  return (lb < SM * SN) && (m < mtiles) && (n < ntiles);
}
__device__ __forceinline__ int super_iters(int mtiles, int ntiles, int SN) {
  const int nbx = gridDim.x >> 3, SM = nbx / SN;
  const int nsuper = ((ntiles + SN - 1) / SN) * ((mtiles + SM - 1) / SM);
  return (nsuper + 7) >> 3;
}
template <class AP, class EP>
__device__ __forceinline__ void gemm_phase(const AP& ap, const u16* Bt, int K, int mtiles, int ntiles, const EP& ep, char* smem, int SN) {
  const int iters = super_iters(mtiles, ntiles, SN);
  for (int it = 0; it < iters; ++it) {
    int m, n;
    if (super_tile(it, mtiles, ntiles, SN, m, n)) gemm_tile(ap, Bt, K, m * 128, n * 128, ep, smem);
  }
}


__device__ __forceinline__ void head_norm_rope(float (&v)[4], const float* __restrict__ gain, const float* __restrict__ rope, int pos, int c16, float outscale) {
  float ss = v[0] * v[0] + v[1] * v[1] + v[2] * v[2] + v[3] * v[3];
  ss += __shfl_xor(ss, 1); ss += __shfl_xor(ss, 2); ss += __shfl_xor(ss, 4); ss += __shfl_xor(ss, 8);
  const float rs = rsqrtf(ss * (1.f / 64.f) + 1e-6f) * outscale;
  const float y0 = v[0] * rs * gain[c16], y1 = v[1] * rs * gain[16 + c16], y2 = v[2] * rs * gain[32 + c16], y3 = v[3] * rs * gain[48 + c16];
  const float2 cs0 = *(const float2*)(rope + ((size_t)pos * 32 + c16) * 2);
  const float2 cs1 = *(const float2*)(rope + ((size_t)pos * 32 + 16 + c16) * 2);
  v[0] = y0 * cs0.x - y2 * cs0.y; v[2] = y0 * cs0.y + y2 * cs0.x;
  v[1] = y1 * cs1.x - y3 * cs1.y; v[3] = y1 * cs1.y + y3 * cs1.x;
}

struct EpAin {
  static constexpr bool TR = true;
  u16* y; u16* zr;
  __device__ __forceinline__ void operator()(f32x4 (&acc)[4][4], int mb, int nb, int lane) const {
    const int c16 = lane & 15, quad = lane >> 4;
#pragma unroll
    for (int mi = 0; mi < 4; ++mi)
#pragma unroll
      for (int ni = 0; ni < 4; ++ni) {
        const int row = mb + mi * 16 + c16, col = nb + ni * 16 + quad * 4;
        uint2 pk;
        if (nb < 1024) {
          pk.x = pack2(gelu_tanh(acc[mi][ni][0]), gelu_tanh(acc[mi][ni][1])); pk.y = pack2(gelu_tanh(acc[mi][ni][2]), gelu_tanh(acc[mi][ni][3]));
          *(uint2*)(y + (size_t)row * 1024 + col) = pk;
        } else {
          pk.x = pack2(acc[mi][ni][0], acc[mi][ni][1]); pk.y = pack2(acc[mi][ni][2], acc[mi][ni][3]);
          *(uint2*)(zr + (size_t)row * 1024 + col - 1024) = pk;
        }
      }
  }
};
struct EpRes {
  static constexpr bool TR = true;
  const float* res; float* out; float sc;
  __device__ __forceinline__ void operator()(f32x4 (&acc)[4][4], int mb, int nb, int lane) const {
    const int c16 = lane & 15, quad = lane >> 4;
#pragma unroll
    for (int mi = 0; mi < 4; ++mi)
#pragma unroll
      for (int ni = 0; ni < 4; ++ni) {
        const size_t idx = (size_t)(mb + mi * 16 + c16) * 1024 + nb + ni * 16 + quad * 4;
        const float4 r = *(const float4*)(res + idx);
        float4 o; o.x = r.x + sc * acc[mi][ni][0]; o.y = r.y + sc * acc[mi][ni][1]; o.z = r.z + sc * acc[mi][ni][2]; o.w = r.w + sc * acc[mi][ni][3];
        *(float4*)(out + idx) = o;
      }
  }
};
struct EpFfn1 {
  static constexpr bool TR = true;
  u16* act;
  __device__ __forceinline__ void operator()(f32x4 (&acc)[4][4], int mb, int nb, int lane) const {
    const int c16 = lane & 15, quad = lane >> 4;
    const int hb = (nb >> 6) * 32;
#pragma unroll
    for (int mi = 0; mi < 4; ++mi)
#pragma unroll
      for (int ni = 0; ni < 2; ++ni) {
        float v[4];
#pragma unroll
        for (int jj = 0; jj < 4; ++jj) { const float g = acc[mi][ni][jj], u = acc[mi][ni + 2][jj]; v[jj] = g / (1.f + __expf(-g)) * u; }
        uint2 pk; pk.x = pack2(v[0], v[1]); pk.y = pack2(v[2], v[3]);
        *(uint2*)(act + (size_t)(mb + mi * 16 + c16) * FHID + hb + ni * 16 + quad * 4) = pk;
      }
  }
};
struct EpKV {
  static constexpr bool TR = false;
  char* ws; const float* knorm; const float* rope;
  __device__ __forceinline__ void operator()(f32x4 (&acc)[4][4], int mb, int nb, int lane) const {
    const int c16 = lane & 15, quad = lane >> 4;
    const int j6 = nb >> 8, g = (nb & 255) >> 6;
    const int b = mb / SEQL, sb = mb - b * SEQL;
    if (j6 < 2) {
      u16* dst = (u16*)(ws + (j6 == 0 ? OFF_KC : OFF_VC));
#pragma unroll
      for (int mi = 0; mi < 4; ++mi)
#pragma unroll
        for (int ni = 0; ni < 4; ++ni)
#pragma unroll
          for (int j = 0; j < 4; ++j)
            dst[(size_t)(mb + mi * 16 + quad * 4 + j) * 256 + g * 64 + ni * 16 + c16] = f2bf(acc[mi][ni][j]);
    } else if (j6 == 2 || j6 == 4) {
      u16* dst = (u16*)(ws + (j6 == 2 ? OFF_KS : OFF_KW));
      const float* gain = knorm + (j6 == 2 ? 64 : 128);
#pragma unroll
      for (int mi = 0; mi < 4; ++mi)
#pragma unroll
        for (int j = 0; j < 4; ++j) {
          const int s = sb + mi * 16 + quad * 4 + j;
          float v[4] = {acc[mi][0][j], acc[mi][1][j], acc[mi][2][j], acc[mi][3][j]};
          head_norm_rope(v, gain, rope, s, c16, 1.f);
#pragma unroll
          for (int ni = 0; ni < 4; ++ni) dst[((size_t)(b * 4 + g) * SEQL + s) * 64 + ni * 16 + c16] = f2bf(v[ni]);
        }
    } else {
      u16* dst = (u16*)(ws + (j6 == 3 ? OFF_VST : OFF_VWT));
#pragma unroll
      for (int mi = 0; mi < 4; ++mi)
#pragma unroll
        for (int ni = 0; ni < 4; ++ni) {
          const int d = ni * 16 + c16, s = sb + mi * 16 + quad * 4;
          uint2 pk; pk.x = pack2(acc[mi][ni][0], acc[mi][ni][1]); pk.y = pack2(acc[mi][ni][2], acc[mi][ni][3]);
          *(uint2*)(dst + ((size_t)(b * 4 + g) * 64 + d) * SEQL + s) = pk;
        }
    }
  }
};
struct EpCmp1 {
  static constexpr bool TR = false;
  u16* hid; const float* pbpart; const float* b1;
  __device__ __forceinline__ void operator()(f32x4 (&acc)[4][4], int mb, int nb, int lane) const {
    const int c16 = lane & 15, quad = lane >> 4;
#pragma unroll
    for (int ni = 0; ni < 4; ++ni) {
      const int col = nb + ni * 16 + c16;
      float pb = b1[col];
      for (int s = 0; s < 16; ++s) pb += pbpart[s * 256 + col];
#pragma unroll
      for (int mi = 0; mi < 4; ++mi)
#pragma unroll
        for (int j = 0; j < 4; ++j)
          hid[(size_t)(mb + mi * 16 + quad * 4 + j) * 256 + col] = f2bf(gelu_tanh(acc[mi][ni][j] + pb));
    }
  }
};
struct EpCmp2 {
  static constexpr bool TR = false;
  char* ws; int kv; const float* b2; const float* knorm; const float* rope;
  __device__ __forceinline__ void operator()(f32x4 (&acc)[4][4], int mb, int nb, int lane) const {
    if (nb & 64) return;
    const int c16 = lane & 15, quad = lane >> 4;
    float bb[4];
#pragma unroll
    for (int ni = 0; ni < 4; ++ni) bb[ni] = b2[ni * 16 + c16];
#pragma unroll
    for (int mi = 0; mi < 4; ++mi)
#pragma unroll
      for (int j = 0; j < 4; ++j) {
        const int row = mb + mi * 16 + quad * 4 + j;
        const int g = row & 3, bc = row >> 2, b = bc / 127, c = bc - b * 127;
        float v[4] = {acc[mi][0][j] + bb[0], acc[mi][1][j] + bb[1], acc[mi][2][j] + bb[2], acc[mi][3][j] + bb[3]};
        if (kv == 0) {
          head_norm_rope(v, knorm, rope, c * 16 + 31, c16, 1.f);
          u16* dst = (u16*)(ws + OFF_KCMP) + ((size_t)(b * 4 + g) * 128 + c) * 64;
#pragma unroll
          for (int ni = 0; ni < 4; ++ni) dst[ni * 16 + c16] = f2bf(v[ni]);
        } else {
          u16* dst = (u16*)(ws + OFF_VCMPT) + (size_t)(b * 4 + g) * 64 * 128 + c;
#pragma unroll
          for (int ni = 0; ni < 4; ++ni) dst[(size_t)(ni * 16 + c16) * 128] = f2bf(v[ni]);
        }
      }
  }
};
__device__ __forceinline__ void head_norm_rope_t(float (&v)[4][4], const float* __restrict__ gain, const float* __restrict__ rope, int pos, int quad, float outscale) {
  float ss = 0.f;
#pragma unroll
  for (int ni = 0; ni < 4; ++ni)
#pragma unroll
    for (int jj = 0; jj < 4; ++jj) ss += v[ni][jj] * v[ni][jj];
  ss += __shfl_xor(ss, 16); ss += __shfl_xor(ss, 32);
  const float rs = rsqrtf(ss * (1.f / 64.f) + 1e-6f) * outscale;
#pragma unroll
  for (int ni = 0; ni < 2; ++ni) {
    const int d = ni * 16 + quad * 4;
    const float4 g1 = *(const float4*)(gain + d), g2 = *(const float4*)(gain + d + 32);
    const float4 csa = *(const float4*)(rope + ((size_t)pos * 32 + d) * 2), csb = *(const float4*)(rope + ((size_t)pos * 32 + d) * 2 + 4);
    const float g1a[4] = {g1.x, g1.y, g1.z, g1.w}, g2a[4] = {g2.x, g2.y, g2.z, g2.w};
    const float cc[4] = {csa.x, csa.z, csb.x, csb.z}, sn[4] = {csa.y, csa.w, csb.y, csb.w};
#pragma unroll
    for (int jj = 0; jj < 4; ++jj) {
      const float y1 = v[ni][jj] * rs * g1a[jj], y2 = v[ni + 2][jj] * rs * g2a[jj];
      v[ni][jj] = y1 * cc[jj] - y2 * sn[jj];
      v[ni + 2][jj] = y1 * sn[jj] + y2 * cc[jj];
    }
  }
}
struct EpQ {
  static constexpr bool TR = true;
  u16* q; float* gates; const float* qnorm; const float* gate_b; const float* rope;
  __device__ __forceinline__ void operator()(f32x4 (&acc)[4][4], int mb, int nb, int lane) const {
    const int c16 = lane & 15, quad = lane >> 4;
    if (nb < 1024) {
      const float osc = 0.125f * 1.4426950408889634f;
#pragma unroll
      for (int mi = 0; mi < 4; ++mi) {
        const int row = mb + mi * 16 + c16;
        float v[4][4];
#pragma unroll
        for (int ni = 0; ni < 4; ++ni)
#pragma unroll
          for (int jj = 0; jj < 4; ++jj) v[ni][jj] = acc[mi][ni][jj];
        head_norm_rope_t(v, qnorm, rope, row & (SEQL - 1), quad, osc);
#pragma unroll
        for (int ni = 0; ni < 4; ++ni) {
          uint2 pk; pk.x = pack2(v[ni][0], v[ni][1]); pk.y = pack2(v[ni][2], v[ni][3]);
          *(uint2*)(q + (size_t)row * 1024 + nb + ni * 16 + quad * 4) = pk;
        }
      }
    } else if (nb == 1024) {
#pragma unroll
      for (int ni = 0; ni < 3; ++ni) {
        const int gi = ni * 16 + quad * 4;
        const float4 gb = *(const float4*)(gate_b + gi);
#pragma unroll
        for (int mi = 0; mi < 4; ++mi) {
          float4 o;
          o.x = sigmoidf_(acc[mi][ni][0] + gb.x); o.y = sigmoidf_(acc[mi][ni][1] + gb.y);
          o.z = sigmoidf_(acc[mi][ni][2] + gb.z); o.w = sigmoidf_(acc[mi][ni][3] + gb.w);
          *(float4*)(gates + (size_t)(mb + mi * 16 + c16) * 48 + gi) = o;
        }
      }
    }
  }
};

#define XB_TMO      128
#define XB_XCNT(j)  (256  + 64 * (j))
#define XB_XSUB(j)  (1280 + 64 * (j))
#define XB_XGEN(j)  (2304 + 64 * (j))
#define XB_TOP      3328
#define XB_TOPGEN   3392
#define XCD_BAR_WORDS 3456
#define XB_SPIN_CAP (1u << 22)
__device__ __forceinline__ unsigned xb_ld(unsigned* p)              { return __hip_atomic_load(p, __ATOMIC_RELAXED, __HIP_MEMORY_SCOPE_AGENT); }
__device__ __forceinline__ unsigned xb_add(unsigned* p, unsigned v) { return __hip_atomic_fetch_add(p, v, __ATOMIC_RELAXED, __HIP_MEMORY_SCOPE_AGENT); }
__device__ __forceinline__ unsigned xb_xcc_id() { return (unsigned)__builtin_amdgcn_s_getreg((3 << 11) | 20) & 0xFu; }
#define XB_SPIN(cond, bar) do { unsigned _sp = 0; while (cond) { __builtin_amdgcn_s_sleep(1); \
    if ((++_sp & 255u) == 0u) { if (xb_ld(&(bar)[XB_TMO])) break; if (_sp > XB_SPIN_CAP) { atomicAdd(&(bar)[XB_TMO], 1u); break; } } } } while (0)
struct XcdBarrier { unsigned* bar; unsigned x; volatile LDS_AS unsigned* st; };
__device__ __forceinline__ XcdBarrier xcd_barrier_post(unsigned* bar, volatile LDS_AS unsigned* st) {
  XcdBarrier b; b.bar = bar; b.x = xb_xcc_id(); b.st = st;
  if (threadIdx.x == 0) (void)xb_add(&bar[XB_XCNT(b.x)], 1u);
  return b;
}
__device__ __forceinline__ void xcd_barrier_complete(unsigned* bar, unsigned x, unsigned& nloc, unsigned& nx) {
  const unsigned G = gridDim.x * gridDim.y * gridDim.z;
  unsigned sum, cnt, mine, sp = 0u;
  for (;;) {
    sum = 0u; cnt = 0u; mine = 0u;
#pragma unroll
    for (unsigned j = 0; j < 16; ++j) { const unsigned c = xb_ld(&bar[XB_XCNT(j)]); sum += c; cnt += (c > 0u) ? 1u : 0u; mine = (j == x) ? c : mine; }
    if (sum == G) break;
    __builtin_amdgcn_s_sleep(1);
    if ((++sp & 255u) == 0u) { if (xb_ld(&bar[XB_TMO])) break; if (sp > XB_SPIN_CAP) { atomicAdd(&bar[XB_TMO], 1u); break; } }
  }
  nloc = mine > 0u ? mine : 1u; nx = cnt > 0u ? cnt : 1u;
}
__device__ __forceinline__ void xcd_barrier(const XcdBarrier& b) {
  asm volatile("s_waitcnt vmcnt(0)" ::: "memory");
  __syncthreads();
  if (threadIdx.x == 0) {
    unsigned* bar = b.bar;
    __builtin_amdgcn_s_waitcnt(0);
    unsigned nloc = b.st[0], nx = b.st[1];
    if (nloc == 0u) { xcd_barrier_complete(bar, b.x, nloc, nx); b.st[0] = nloc; b.st[1] = nx; }
    const unsigned old = xb_add(&bar[XB_XSUB(b.x)], 1u);
    const unsigned gen = old / nloc;
    if (old + 1u == (gen + 1u) * nloc) {
      __builtin_amdgcn_fence(__ATOMIC_RELEASE, "agent");
      asm volatile("s_waitcnt vmcnt(0)" ::: "memory");
      const unsigned og = xb_add(&bar[XB_TOP], 1u);
      const unsigned tg = og / nx;
      if (og + 1u == (tg + 1u) * nx) xb_add(&bar[XB_TOPGEN], 1u);
      else XB_SPIN(xb_ld(&bar[XB_TOPGEN]) == tg, bar);
      __builtin_amdgcn_fence(__ATOMIC_ACQUIRE, "agent");
      xb_add(&bar[XB_XGEN(b.x)], 1u);
      asm volatile("s_waitcnt vmcnt(0)" ::: "memory");
    } else {
      XB_SPIN(xb_ld(&bar[XB_XGEN(b.x)]) == gen, bar);
      __builtin_amdgcn_fence(__ATOMIC_ACQUIRE, "agent");
      asm volatile("s_waitcnt vmcnt(0)" ::: "memory");
    }
  }
  __syncthreads();
}

__device__ __forceinline__ void norm_phase(const float* __restrict__ h, const float* __restrict__ g, u16* __restrict__ u) {
  const int tidn = otid();
  const int lane = tidn & 63;
  const int gw = blockIdx.x * 4 + (tidn >> 6), nw = gridDim.x * 4;
  float4 gv[4];
#pragma unroll
  for (int i = 0; i < 4; ++i) gv[i] = *(const float4*)(g + i * 256 + lane * 4);
  for (int row = gw; row < T_TOK; row += nw) {
    const float* hr = h + (size_t)row * 1024;
    float4 v[4];
    float ss = 0.f;
#pragma unroll
    for (int i = 0; i < 4; ++i) { { const f32x4 t_ = __builtin_nontemporal_load((const f32x4*)(hr + i * 256 + lane * 4)); v[i] = make_float4(t_[0], t_[1], t_[2], t_[3]); } ss += v[i].x * v[i].x + v[i].y * v[i].y + v[i].z * v[i].z + v[i].w * v[i].w; }
#pragma unroll
    for (int o = 32; o >= 1; o >>= 1) ss += __shfl_xor(ss, o);
    const float rs = rsqrtf(ss * (1.f / 1024.f) + 1e-6f);
#pragma unroll
    for (int i = 0; i < 4; ++i) {
      uint2 pk; pk.x = pack2(v[i].x * rs * gv[i].x, v[i].y * rs * gv[i].y); pk.y = pack2(v[i].z * rs * gv[i].z, v[i].w * rs * gv[i].w);
      *(uint2*)(u + (size_t)row * 1024 + i * 256 + lane * 4) = pk;
    }
  }
}

__device__ __forceinline__ void do_transpose(const float* __restrict__ src, u16* __restrict__ dst, int K, int N, int Nd, int mode, int t, char* smem) {
  float* tile = (float*)smem;
  const int tid = otid();
  const int ktn = K >> 6, tpb = ktn * (Nd >> 6);
  const int bi = t / tpb, r = t - bi * tpb, nt = r / ktn, kt = r - nt * ktn;
  const float* sb = src + (size_t)bi * K * N;
  u16* db = dst + (size_t)bi * Nd * K;
  __syncthreads();
#pragma unroll 4
  for (int i = 0; i < 16; ++i) {
    const int e = tid + i * 256, kk = e >> 6, nn = e & 63;
    const int n1 = nt * 64 + nn;
    int sc = n1;
    if (mode == 1) { const int blk = n1 >> 6, rr = n1 & 63; const int hid = blk * 32 + (rr & 31); sc = (rr < 32) ? hid : (FHID + hid); }
    tile[kk * 65 + nn] = (sc < N) ? sb[(size_t)(kt * 64 + kk) * N + sc] : 0.f;
  }
  __syncthreads();
#pragma unroll 4
  for (int i = 0; i < 16; ++i) {
    const int e = tid + i * 256, nn = e >> 6, kk = e & 63;
    db[(size_t)(nt * 64 + nn) * K + kt * 64 + kk] = f2bf(tile[kk * 65 + nn]);
  }
}

__device__ __forceinline__ void prep_phase(const KArgs& a, char* smem) {
  char* ws = a.ws;
  constexpr int TOTAL = PREP_TILES;
  for (int tile = blockIdx.x; tile < TOTAL; tile += gridDim.x) {
    int t = tile;
#define JOB(S, D, K_, N_, ND_, B_, M_)                                                               \
    { constexpr int cnt = (B_) * ((K_) / 64) * ((ND_) / 64);                                         \
      if (t >= 0 && t < cnt) do_transpose((S), (u16*)(ws + (D)), (K_), (N_), (ND_), (M_), t, smem);  \
      t -= cnt; }
    JOB(a.in[I_AWIN],   OFF_W_AIN,  1024, 2048, 2048, 2, 0)
    JOB(a.in[I_AWOUT],  OFF_W_AOUT, 1024, 1024, 1024, 2, 0)
    JOB(a.in[I_KVW],    OFF_W_KV,   1024, 1536, 1536, 1, 0)
    JOB(a.in[I_CMPW1],  OFF_W_C1,   2048, 256,  256,  2, 0)
    JOB(a.in[I_CMPW2],  OFF_W_C2,   256,  64,   128,  2, 0)
    JOB(a.in[I_BWIN],   OFF_W_BIN,  1024, 1072, 1152, 2, 0)
    JOB(a.in[I_BWOUT],  OFF_W_BOUT, 1024, 1024, 1024, 2, 0)
    JOB(a.in[I_FWIN],   OFF_W_FIN,  1024, 5632, 5632, 4, 1)
    JOB(a.in[I_FWOUT],  OFF_W_FOUT, 2816, 1024, 1024, 4, 0)
#undef JOB
  }
  const int tidp = otid();
  const int gt = blockIdx.x * NTHREADS + tidp, ng = gridDim.x * NTHREADS;
  for (int i = gt; i < 2048; i += ng) ((unsigned*)(ws + OFF_FLAG))[i] = 0u;
  {
    const float* gsrc = (const float*)(ws + OFF_HID);
    u16* gdst = (u16*)(ws + OFF_W_GATE);
    for (int i = gt; i < 2 * 2048 * 128; i += ng) {
      const int Lg = i >> 18, n = (i >> 7) & 2047, k = i & 127;
      const int hd = n >> 8, rp = n & 255, half = rp >> 7, q = (rp & 127) >> 6, rr = rp & 63, gate = rr >> 5;
      const int chl = half * 64 + q * 32 + (rr & 31);
      gdst[i] = f2bf(gsrc[((size_t)((Lg * 2 + gate) * 8 + hd) * 128 + k) * 128 + chl]);
    }
  }
  float* rope = (float*)(ws + OFF_ROPE);
  for (int i = gt; i < 2048 * 32; i += ng) {
    const int pos = i >> 5, fi = i & 31;
    const double freq = exp2(-(double)fi * (13.287712379549449 / 32.0));
    const double ang = (double)pos * freq;
    const double n = rint(ang * 0.15915494309189535);
    const float r = (float)(ang - n * 6.283185307179586);
    rope[2 * i] = cosf(r); rope[2 * i + 1] = sinf(r);
  }
  float* pb = (float*)(ws + OFF_PB);
  for (int it = blockIdx.x; it < 32; it += gridDim.x) {
    const int kv = it >> 4, ks = it & 15, n = tidp;
    const float* pos = a.in[I_CMPPOS] + kv * 2048 + ks * 128;
    const float* w1 = a.in[I_CMPW1] + ((size_t)kv * 2048 + ks * 128) * 256 + n;
    float s = 0.f;
    for (int k = 0; k < 128; ++k) s += pos[k] * w1[(size_t)k * 256];
    pb[(kv * 16 + ks) * 256 + n] = s;
  }
  u16* kcmp = (u16*)(ws + OFF_KCMP); u16* vcmpt = (u16*)(ws + OFF_VCMPT);
  for (int i = gt; i < 128 * 64; i += ng) {
    const int bg = i >> 6, d = i & 63;
    kcmp[((size_t)bg * 128 + 127) * 64 + d] = 0;
    vcmpt[((size_t)bg * 64 + d) * 128 + 127] = 0;
  }
}

__device__ __forceinline__ void conv_phase(const KArgs& a, int L) {
  const u16* ZR = (const u16*)(a.ws + OFF_BUFA) + (size_t)T_TOK * 1024;
  u16* XR = (u16*)(a.ws + OFF_U);
  const int gt = blockIdx.x * NTHREADS + otid(), ng = gridDim.x * NTHREADS;
  const int ch0 = (gt & 127) * 8;
  float cw[4][8], cb[8];
#pragma unroll
  for (int c = 0; c < 8; ++c) {
    cb[c] = a.in[I_ACONVB][(size_t)L * 1024 + ch0 + c];
#pragma unroll
    for (int k = 0; k < 4; ++k) cw[k][c] = a.in[I_ACONVW][(size_t)(L * 4 + k) * 1024 + ch0 + c];
  }
  for (int unit = gt; unit < (T_TOK / 16) * 128; unit += ng) {
    const int t0 = (unit >> 7) * 16, s0 = t0 & (SEQL - 1);
    const u16* src = ZR + (size_t)t0 * 1024 + ch0;
    uint4 rows[19];
#pragma unroll
    for (int r = 0; r < 19; ++r) {
      if (s0 + r - 3 >= 0) { const u32x4 t_ = __builtin_nontemporal_load((const u32x4*)(src + (ptrdiff_t)(r - 3) * 1024)); rows[r] = make_uint4(t_[0], t_[1], t_[2], t_[3]); }
      else rows[r] = make_uint4(0u, 0u, 0u, 0u);
    }
#pragma unroll
    for (int i = 0; i < 16; ++i) {
      float o[8];
#pragma unroll
      for (int c = 0; c < 8; ++c) o[c] = cb[c];
#pragma unroll
      for (int k = 0; k < 4; ++k) {
        const uint4 v = rows[i + k];
        const unsigned wv[4] = {v.x, v.y, v.z, v.w};
#pragma unroll
        for (int c = 0; c < 4; ++c) {
          o[2 * c] += cw[k][2 * c] * __uint_as_float(wv[c] << 16);
          o[2 * c + 1] += cw[k][2 * c + 1] * __uint_as_float(wv[c] & 0xffff0000u);
        }
      }
      uint4 pk; pk.x = pack2(o[0], o[1]); pk.y = pack2(o[2], o[3]); pk.z = pack2(o[4], o[5]); pk.w = pack2(o[6], o[7]);
      *(uint4*)(XR + (size_t)(t0 + i) * 1024 + ch0) = pk;
    }
  }
}

struct EpGate {
  static constexpr bool TR = false;
  const u16* xr; u16* la; u16* bv; const float* gb; const float* lam;
  __device__ __forceinline__ void operator()(f32x4 (&acc)[4][4], int mb, int nb, int lane) const {
    const int c16 = lane & 15, quad = lane >> 4;
    const int chb = (nb >> 8) * 128 + ((nb >> 7) & 1) * 64 + ((nb >> 6) & 1) * 32;
#pragma unroll
    for (int ni = 0; ni < 2; ++ni) {
      const int ch = chb + ni * 16 + c16;
      const float g0b = gb[ch], g1b = gb[1024 + ch];
      const float cl = -8.f * log1pf(expf(-lam[ch]));
#pragma unroll
      for (int mi = 0; mi < 4; ++mi)
#pragma unroll
        for (int j = 0; j < 4; ++j) {
          const size_t idx = (size_t)(mb + mi * 16 + quad * 4 + j) * 1024 + ch;
          const float r = 1.f / (1.f + __expf(-(acc[mi][ni][j] + g0b)));
          const float ig = 1.f / (1.f + __expf(-(acc[mi][ni + 2][j] + g1b)));
          const float l = cl * r;
          const float av = __expf(l);
          const float bt = sqrtf(fmaxf(1.f - av * av, 0.f)) * (ig * bf2f(xr[idx]));
          la[idx] = f2bf(l); bv[idx] = f2bf(bt);
        }
    }
  }
};

__device__ __forceinline__ void gates_phase(const KArgs& a, int L, char* smem) {
  char* ws = a.ws;
  const u16* XR = (const u16*)(ws + OFF_U);
  EpGate ep{XR, (u16*)(ws + OFF_BUFA) + (size_t)T_TOK * 1024, (u16*)(ws + OFF_KC), a.in[I_AGATEB] + (size_t)L * 2048, a.in[I_ALAM] + (size_t)L * 1024};
  const u16* Bt = (const u16*)(ws + OFF_W_GATE) + (size_t)L * 2048 * 128;
  const int iters = super_iters(512, 16, 4);
  for (int it = 0; it < iters; ++it) {
    int m, n;
    if (super_tile(it, 512, 16, 4, m, n)) {
      APlain ap{XR + (n >> 1) * 128, 1024};
      gemm_tile(ap, Bt, 128, m * 128, n * 128, ep, smem);
    }
  }
}

__device__ __forceinline__ void scan_phase(const KArgs& a, char* smem) {
  float* sP = (float*)smem; float* sH = sP + 256;
  const int tid = otid(), lane = tid & 63, w = tid >> 6;
  const u16* Y = (const u16*)(a.ws + OFF_BUFA);
  const u16* LA = Y + (size_t)T_TOK * 1024;
  const u16* BV = (const u16*)(a.ws + OFF_KC);
  u16* YH = (u16*)(a.ws + OFF_U);
  for (int item = blockIdx.x; item < 512; item += gridDim.x) {
    const int b = item >> 4, ch = (item & 15) * 64 + lane;
    const size_t base = ((size_t)b * SEQL + w * 512) * 1024 + ch;
    float P = 1.f, H = 0.f;
    for (int t = 0; t < 512; t += 16) {
      u16 l8[16], b8[16];
#pragma unroll
      for (int i = 0; i < 16; ++i) { l8[i] = LA[base + (size_t)(t + i) * 1024]; b8[i] = BV[base + (size_t)(t + i) * 1024]; }
#pragma unroll
      for (int i = 0; i < 16; ++i) { const float av = __expf(bf2f(l8[i])); H = av * H + bf2f(b8[i]); P *= av; }
    }
    __syncthreads();
    sP[w * 64 + lane] = P; sH[w * 64 + lane] = H;
    __syncthreads();
    float h = 0.f;
    for (int s2 = 0; s2 < w; ++s2) h = sP[s2 * 64 + lane] * h + sH[s2 * 64 + lane];
    for (int t = 0; t < 512; t += 16) {
      u16 l8[16], b8[16], y8[16];
#pragma unroll
      for (int i = 0; i < 16; ++i) { const size_t idx = base + (size_t)(t + i) * 1024; l8[i] = __builtin_nontemporal_load(LA + idx); b8[i] = __builtin_nontemporal_load(BV + idx); y8[i] = __builtin_nontemporal_load(Y + idx); }
#pragma unroll
      for (int i = 0; i < 16; ++i) {
        h = __expf(bf2f(l8[i])) * h + bf2f(b8[i]);
        YH[base + (size_t)(t + i) * 1024] = f2bf(bf2f(y8[i]) * h);
      }
    }
  }
}

#define SM_SHIFT 8.0f
__device__ __forceinline__ void qk_tile(const u16* Ks, const bf16x8 (&qf)[2][2], f32x4 (&S)[4][2], int c16, int quad) {
#pragma unroll
  for (int mb = 0; mb < 4; ++mb) {
#pragma unroll
    for (int nb = 0; nb < 2; ++nb) S[mb][nb] = f32x4{-SM_SHIFT, -SM_SHIFT, -SM_SHIFT, -SM_SHIFT};
#pragma unroll
    for (int ks = 0; ks < 2; ++ks) {
      const bf16x8 kf = *(const bf16x8*)(Ks + (mb * 16 + c16) * 72 + ks * 32 + quad * 8);
#pragma unroll
      for (int nb = 0; nb < 2; ++nb) S[mb][nb] = mfma16(kf, qf[nb][ks], S[mb][nb]);
    }
  }
}
__device__ __forceinline__ void pv_tile(const u16* Vs, int koff, const f32x4 (&P)[4][2], f32x4 (&O)[4][2], int c16, int quad) {
#pragma unroll
  for (int kk = 0; kk < 2; ++kk) {
    bf16x8 pf[2];
#pragma unroll
    for (int nb = 0; nb < 2; ++nb) {
      u32x4 t;
      t.x = pack2(P[2 * kk][nb][0], P[2 * kk][nb][1]); t.y = pack2(P[2 * kk][nb][2], P[2 * kk][nb][3]);
      t.z = pack2(P[2 * kk + 1][nb][0], P[2 * kk + 1][nb][1]); t.w = pack2(P[2 * kk + 1][nb][2], P[2 * kk + 1][nb][3]);
      pf[nb] = __builtin_bit_cast(bf16x8, t);
    }
#pragma unroll
    for (int db = 0; db < 4; ++db) {
      const u16* vp = Vs + (db * 16 + c16) * 136 + koff + kk * 32 + quad * 4;
      const uint2 lo = *(const uint2*)vp, hi = *(const uint2*)(vp + 16);
      u32x4 t; t.x = lo.x; t.y = lo.y; t.z = hi.x; t.w = hi.y;
      const bf16x8 vf = __builtin_bit_cast(bf16x8, t);
#pragma unroll
      for (int nb = 0; nb < 2; ++nb) O[db][nb] = mfma16(vf, pf[nb], O[db][nb]);
    }
  }
}

template <bool NOMASK, class MaskF>
__device__ __forceinline__ void flash_step(const u16* Ks, const u16* Vs, const bf16x8 (&qf)[2][2], f32x4 (&O)[4][2], float (&m)[2], float (&l)[2],
                                           const MaskF& valid, int c16, int quad) {
  f32x4 S[4][2];
  qk_tile(Ks, qf, S, c16, quad);
#pragma unroll
  for (int nb = 0; nb < 2; ++nb) {
    float rs = 0.f;
#pragma unroll
    for (int mb = 0; mb < 4; ++mb)
#pragma unroll
      for (int j = 0; j < 4; ++j) {
        const float pv = (NOMASK || valid(nb, mb * 16 + j)) ? __builtin_amdgcn_exp2f(S[mb][nb][j]) : 0.f;
        S[mb][nb][j] = pv; rs += pv;
      }
    rs += __shfl_xor(rs, 16); rs += __shfl_xor(rs, 32);
    l[nb] += rs;
  }
  pv_tile(Vs, 0, S, O, c16, quad);
}

__device__ __forceinline__ void attn_phase(const KArgs& a, char* smem) {
  u16* Ks = (u16*)smem;
  u16* Vs = (u16*)(smem + 18432);
  float* impM = (float*)(smem + 35840);
  float* impT = (float*)(smem + 35840 + 16896);
  float* sc = (float*)(smem + 69632);
  unsigned* selm = (unsigned*)(smem + 73856);
  unsigned* anyj = selm + 32;
  const u16* Q = (const u16*)(a.ws + OFF_BUFA);
  u16* Oo = (u16*)(a.ws + OFF_BUFA) + (size_t)T_TOK * 1024;
  const float* gates = (const float*)(a.ws + OFF_GATES);
  const u16* kcmp = (const u16*)(a.ws + OFF_KCMP); const u16* vcmpt = (const u16*)(a.ws + OFF_VCMPT);
  const u16* ksl = (const u16*)(a.ws + OFF_KS); const u16* kwn = (const u16*)(a.ws + OFF_KW);
  const u16* vst = (const u16*)(a.ws + OFF_VST); const u16* vwt = (const u16*)(a.ws + OFF_VWT);

  for (int item = blockIdx.x; item < 8192; item += gridDim.x) {
    const int tid = otid(), lane = tid & 63, w = tid >> 6, c16 = lane & 15, quad = lane >> 4;
    const int qt = 63 - (item >> 7), bg = item & 127, b = bg >> 2, g = bg & 3;
    const int s0 = qt * 32, hq = g * 4 + w;
    const size_t tok0 = (size_t)b * SEQL + s0;
    bf16x8 qf[2][2];
#pragma unroll
    for (int nb = 0; nb < 2; ++nb)
#pragma unroll
      for (int ks = 0; ks < 2; ++ks) qf[nb][ks] = *(const bf16x8*)(Q + (tok0 + nb * 16 + c16) * 1024 + hq * 64 + ks * 32 + quad * 8);
    int tq[2]; tq[0] = s0 + c16; tq[1] = s0 + 16 + c16;
    f32x4 of[4][2];
#pragma unroll
    for (int db = 0; db < 4; ++db)
#pragma unroll
      for (int nb = 0; nb < 2; ++nb) of[db][nb] = f32x4{0.f, 0.f, 0.f, 0.f};

    __syncthreads();
    {
      const u16* kc = kcmp + (size_t)bg * 128 * 64;
      const u16* vc = vcmpt + (size_t)bg * 64 * 128;
#pragma unroll
      for (int i = 0; i < 4; ++i) {
        const int id = tid + i * 256;
        { const int r = id >> 3, c = id & 7; *(uint4*)(Ks + r * 72 + c * 8) = *(const uint4*)(kc + r * 64 + c * 8); }
        { const int r = id >> 4, c = id & 15; *(uint4*)(Vs + r * 136 + c * 8) = *(const uint4*)(vc + r * 128 + c * 8); }
      }
      if (tid < 32) selm[tid] = 0u;
      if (tid == 32) *anyj = 0u;
    }
    __syncthreads();
    {
      int cmax[2]; cmax[0] = ((tq[0] - 31) >> 4) - quad * 4; cmax[1] = ((tq[1] - 31) >> 4) - quad * 4;
      float lC[2] = {0.f, 0.f};
#pragma unroll
      for (int h = 0; h < 2; ++h) {
        f32x4 S[4][2];
        qk_tile(Ks + h * 64 * 72, qf, S, c16, quad);
#pragma unroll
        for (int nb = 0; nb < 2; ++nb) {
          float rs = 0.f;
#pragma unroll
          for (int mb = 0; mb < 4; ++mb)
#pragma unroll
            for (int j = 0; j < 4; ++j) rs += (h * 64 + mb * 16 + j <= cmax[nb]) ? __builtin_amdgcn_exp2f(S[mb][nb][j]) : 0.f;
          rs += __shfl_xor(rs, 16); rs += __shfl_xor(rs, 32);
          lC[nb] += rs;
        }
      }
      float invC[2]; invC[0] = (lC[0] > 0.f) ? 1.f / lC[0] : 0.f; invC[1] = (lC[1] > 0.f) ? 1.f / lC[1] : 0.f;
      f32x4 Oc[4][2];
#pragma unroll
      for (int db = 0; db < 4; ++db)
#pragma unroll
        for (int nb = 0; nb < 2; ++nb) Oc[db][nb] = f32x4{0.f, 0.f, 0.f, 0.f};
#pragma unroll
      for (int h = 0; h < 2; ++h) {
        f32x4 S[4][2];
        qk_tile(Ks + h * 64 * 72, qf, S, c16, quad);
#pragma unroll
        for (int nb = 0; nb < 2; ++nb)
#pragma unroll
          for (int mb = 0; mb < 4; ++mb) {
#pragma unroll
            for (int j = 0; j < 4; ++j)
              S[mb][nb][j] = (h * 64 + mb * 16 + j <= cmax[nb]) ? __builtin_amdgcn_exp2f(S[mb][nb][j]) * invC[nb] : 0.f;
            const int jb = h * 16 + mb * 4 + quad;
            const int idx = (w * 32 + nb * 16 + c16) * 33 + jb;
            impM[idx] = S[mb][nb][0] + S[mb][nb][1] + S[mb][nb][2] + 0.5f * S[mb][nb][3];
            impT[idx] = 0.5f * S[mb][nb][3];
          }
        pv_tile(Vs, h * 64, S, Oc, c16, quad);
      }
#pragma unroll
      for (int nb = 0; nb < 2; ++nb) {
        const float gc = gates[(tok0 + nb * 16 + c16) * 48 + hq];
#pragma unroll
        for (int db = 0; db < 4; ++db) of[db][nb] += Oc[db][nb] * gc;
      }
      __syncthreads();
      {
        const int qq = tid & 31, jg = tid >> 5;
        const int cur = (s0 + qq) >> 6;
#pragma unroll
        for (int k = 0; k < 4; ++k) {
          const int j = jg * 4 + k;
          float imp = 0.f;
#pragma unroll
          for (int ww = 0; ww < 4; ++ww) {
            imp += impM[(ww * 32 + qq) * 33 + j];
            if (j > 0) imp += impT[(ww * 32 + qq) * 33 + j - 1];
          }
          float s = imp;
          if (j > cur) s = -1e30f; else if (j == 0 || cur - j < 2) s = 1e30f;
          sc[qq * 33 + j] = s;
        }
        __syncthreads();
        unsigned bits = 0u;
#pragma unroll
        for (int k = 0; k < 4; ++k) {
          const int j = jg * 4 + k;
          const float sj = sc[qq * 33 + j];
          int cnt = 0;
          for (int i = 0; i < 32; ++i) { const float si = sc[qq * 33 + i]; cnt += (si > sj || (si == sj && i < j)) ? 1 : 0; }
          if (cnt < 16) bits |= 1u << j;
        }
        atomicOr(&selm[qq], bits);
        atomicOr(anyj, bits);
      }
    }
    __syncthreads();
    unsigned sel[2]; sel[0] = selm[c16]; sel[1] = selm[16 + c16];
    const unsigned anym = *anyj;

    {
      f32x4 O2[4][2]; float m[2] = {-1e30f, -1e30f}, l[2] = {0.f, 0.f};
#pragma unroll
      for (int db = 0; db < 4; ++db)
#pragma unroll
        for (int nb = 0; nb < 2; ++nb) O2[db][nb] = f32x4{0.f, 0.f, 0.f, 0.f};
      const int jmax = (s0 + 31) >> 6;
      unsigned rem = anym & ((2u << jmax) - 1u);
      const int r0 = tid >> 3, c0 = tid & 7;
      const u16* kbase = ksl + (size_t)bg * SEQL * 64 + r0 * 64 + c0 * 8;
      const u16* vbase = vst + (size_t)bg * 64 * SEQL + (size_t)r0 * SEQL + c0 * 8;
      uint4 rk0, rk1, rv0, rv1;
      int j = __ffs(rem) - 1;
      rk0 = *(const uint4*)(kbase + (size_t)j * 64 * 64); rk1 = *(const uint4*)(kbase + (size_t)j * 64 * 64 + 32 * 64);
      rv0 = *(const uint4*)(vbase + j * 64); rv1 = *(const uint4*)(vbase + j * 64 + (size_t)32 * SEQL);
      for (;;) {
        rem &= rem - 1u;
        __syncthreads();
        *(uint4*)(Ks + r0 * 72 + c0 * 8) = rk0; *(uint4*)(Ks + (r0 + 32) * 72 + c0 * 8) = rk1;
        *(uint4*)(Vs + r0 * 136 + c0 * 8) = rv0; *(uint4*)(Vs + (r0 + 32) * 136 + c0 * 8) = rv1;
        __syncthreads();
        const int jn = rem ? (__ffs(rem) - 1) : -1;
        if (jn >= 0) {
          rk0 = *(const uint4*)(kbase + (size_t)jn * 64 * 64); rk1 = *(const uint4*)(kbase + (size_t)jn * 64 * 64 + 32 * 64);
          rv0 = *(const uint4*)(vbase + jn * 64); rv1 = *(const uint4*)(vbase + jn * 64 + (size_t)32 * SEQL);
        }
        int lim[2];
        lim[0] = ((sel[0] >> j) & 1u) ? (tq[0] - j * 64 - quad * 4) : -1;
        lim[1] = ((sel[1] >> j) & 1u) ? (tq[1] - j * 64 - quad * 4) : -1;
        auto valid = [&](int nb, int kk) -> bool { return kk <= lim[nb]; };
        const bool full = (j * 64 + 63 <= s0) && __all((int)(((sel[0] >> j) & (sel[1] >> j)) & 1u));
        if (full) flash_step<true>(Ks, Vs, qf, O2, m, l, valid, c16, quad);
        else flash_step<false>(Ks, Vs, qf, O2, m, l, valid, c16, quad);
        if (jn < 0) break;
        j = jn;
      }
#pragma unroll
      for (int nb = 0; nb < 2; ++nb) {
        const float gs = gates[(tok0 + nb * 16 + c16) * 48 + 16 + hq] * ((l[nb] > 0.f) ? 1.f / l[nb] : 0.f);
#pragma unroll
        for (int db = 0; db < 4; ++db) of[db][nb] += O2[db][nb] * gs;
      }
    }
    {
      f32x4 O3[4][2]; float m[2] = {-1e30f, -1e30f}, l[2] = {0.f, 0.f};
#pragma unroll
      for (int db = 0; db < 4; ++db)
#pragma unroll
        for (int nb = 0; nb < 2; ++nb) O3[db][nb] = f32x4{0.f, 0.f, 0.f, 0.f};
      const int jlo = (s0 >= 511) ? ((s0 - 511) >> 6) : 0, jhi = (s0 + 31) >> 6;
      const int r0 = tid >> 3, c0 = tid & 7;
      const u16* kbase = kwn + (size_t)bg * SEQL * 64 + r0 * 64 + c0 * 8;
      const u16* vbase = vwt + (size_t)bg * 64 * SEQL + (size_t)r0 * SEQL + c0 * 8;
      uint4 rk0, rk1, rv0, rv1;
      rk0 = *(const uint4*)(kbase + (size_t)jlo * 64 * 64); rk1 = *(const uint4*)(kbase + (size_t)jlo * 64 * 64 + 32 * 64);
      rv0 = *(const uint4*)(vbase + jlo * 64); rv1 = *(const uint4*)(vbase + jlo * 64 + (size_t)32 * SEQL);
      for (int j = jlo; j <= jhi; ++j) {
        __syncthreads();
        *(uint4*)(Ks + r0 * 72 + c0 * 8) = rk0; *(uint4*)(Ks + (r0 + 32) * 72 + c0 * 8) = rk1;
        *(uint4*)(Vs + r0 * 136 + c0 * 8) = rv0; *(uint4*)(Vs + (r0 + 32) * 136 + c0 * 8) = rv1;
        __syncthreads();
        if (j < jhi) {
          const int jn = j + 1;
          rk0 = *(const uint4*)(kbase + (size_t)jn * 64 * 64); rk1 = *(const uint4*)(kbase + (size_t)jn * 64 * 64 + 32 * 64);
          rv0 = *(const uint4*)(vbase + jn * 64); rv1 = *(const uint4*)(vbase + jn * 64 + (size_t)32 * SEQL);
        }
        int lim[2]; lim[0] = tq[0] - j * 64 - quad * 4; lim[1] = tq[1] - j * 64 - quad * 4;
        auto valid = [&](int nb, int kk) -> bool { return (kk <= lim[nb]) && (kk > lim[nb] - 512); };
        const bool full = (j * 64 + 63 <= s0) && (j * 64 > s0 + 31 - 512);
        if (full) flash_step<true>(Ks, Vs, qf, O3, m, l, valid, c16, quad);
        else flash_step<false>(Ks, Vs, qf, O3, m, l, valid, c16, quad);
      }
#pragma unroll
      for (int nb = 0; nb < 2; ++nb) {
        const float gs = gates[(tok0 + nb * 16 + c16) * 48 + 32 + hq] * ((l[nb] > 0.f) ? 1.f / l[nb] : 0.f);
#pragma unroll
        for (int db = 0; db < 4; ++db) of[db][nb] += O3[db][nb] * gs;
      }
    }
#pragma unroll
    for (int nb = 0; nb < 2; ++nb)
#pragma unroll
      for (int db = 0; db < 4; ++db) {
        uint2 pk; pk.x = pack2(of[db][nb][0], of[db][nb][1]); pk.y = pack2(of[db][nb][2], of[db][nb][3]);
        *(uint2*)(Oo + (tok0 + nb * 16 + c16) * 1024 + hq * 64 + db * 16 + quad * 4) = pk;
      }
  }
}

__device__ __forceinline__ bool dbg_bad(float got, float ref) { return !(fabsf(got - ref) <= 0.03f + 0.04f * fabsf(ref)); }
__device__ __forceinline__ void check_ain(const KArgs& a) {
  const int gt = blockIdx.x * NTHREADS + otid();
  if (gt >= 65536) return;
  const unsigned s = (unsigned)gt;
  const int row = (int)(s & 31u) * 2048, col = (int)(s >> 5);
  const int b = row >> 11, ch = col & 1023;
  const u16* u = (const u16*)(a.ws + OFF_U) + (size_t)row * 1024;
  const float* w = a.in[I_AWIN] + col;
  float acc = 0.f;
  for (int k = 0; k < 1024; ++k) acc += bf2f(u[k]) * w[(size_t)k * 2048];
  const u16* Y = (const u16*)(a.ws + OFF_BUFA);
  float got, ref;
  if (col < 1024) { got = bf2f(Y[(size_t)row * 1024 + col]); ref = gelu_tanh(acc); }
  else { got = bf2f(Y[(size_t)T_TOK * 1024 + (size_t)row * 1024 + col - 1024]); ref = acc; }
  if (dbg_bad(got, ref)) { atomicAdd((unsigned*)(a.ws + OFF_FLAG), 1u); ((unsigned*)(a.ws + OFF_FLAG))[16 + ch] = 1u; ((unsigned*)(a.ws + OFF_FLAG))[1100 + b] = 1u; }

}
__device__ __forceinline__ void check_scan(const KArgs& a) {
  const int gt = blockIdx.x * NTHREADS + otid();
  if (gt >= 32768) return;
  const unsigned s = (unsigned)gt;
  const int b = (int)(s & 31u), ch = (int)(s >> 5), hd = ch >> 7;
  const u16* Y = (const u16*)(a.ws + OFF_BUFA);
  const u16* ZR = Y + (size_t)T_TOK * 1024;
  const float* gw = (const float*)(a.ws + OFF_HID);
  const float lam = a.in[I_ALAM][ch];
  const float cl = -8.f * log1pf(expf(-lam));
  float h = 0.f;
  bool bad = false;
  for (int t = 0; t < 1; ++t) {
    float g0 = a.in[I_AGATEB][ch], g1 = a.in[I_AGATEB][1024 + ch], xme = 0.f;
    for (int i = 0; i < 128; ++i) {
      const int ci = hd * 128 + i;
      float xr = a.in[I_ACONVB][ci];
      for (int k = 0; k < 4; ++k) { const int tt = t - 3 + k; if (tt >= 0) xr += a.in[I_ACONVW][k * 1024 + ci] * bf2f(ZR[((size_t)b * SEQL + tt) * 1024 + ci]); }
      g0 += xr * gw[((size_t)(0 * 8 + hd) * 128 + i) * 128 + (ch & 127)];
      g1 += xr * gw[((size_t)(1 * 8 + hd) * 128 + i) * 128 + (ch & 127)];
      if (ci == ch) xme = xr;
    }
    const float r = 1.f / (1.f + expf(-g0)), ig = 1.f / (1.f + expf(-g1));
    const float la = cl * r, av = expf(la), bt = sqrtf(fmaxf(-expm1f(2.f * la), 0.f)) * ig * xme;
    h = av * h + bt;
    const u16* u = (const u16*)(a.ws + OFF_U) + ((size_t)b * SEQL + t) * 1024;
    float acc = 0.f;
    for (int k = 0; k < 1024; ++k) acc += bf2f(u[k]) * a.in[I_AWIN][(size_t)k * 2048 + ch];
    const float ref = gelu_tanh(acc) * h;
    const float got = bf2f(Y[((size_t)b * SEQL + t) * 1024 + ch]);
    if (t == 0 && dbg_bad(got, ref)) { atomicAdd((unsigned*)(a.ws + OFF_FLAG), 1u); ((unsigned*)(a.ws + OFF_FLAG))[16 + ch] = 1u; ((unsigned*)(a.ws + OFF_FLAG))[1100 + b] = 1u; }
  }
}
__device__ __forceinline__ void check_ffn1(const KArgs& a) {
  const int gt = blockIdx.x * NTHREADS + otid();
  if (gt >= 8192) return;
  const unsigned s = (unsigned)gt;
  const int row = (int)((s * 2654435761u) >> 16), hid = (int)((s * 40503u + 17u) % 2816u);
  const u16* u = (const u16*)(a.ws + OFF_U) + (size_t)row * 1024;
  const float* w = a.in[I_FWIN];
  float g = 0.f, up = 0.f;
  for (int k = 0; k < 1024; ++k) { const float uv = bf2f(u[k]); g += uv * w[(size_t)k * 5632 + hid]; up += uv * w[(size_t)k * 5632 + 2816 + hid]; }
  const float ref = g / (1.f + expf(-g)) * up;
  const float got = bf2f(((const u16*)(a.ws + OFF_BUFA))[(size_t)row * FHID + hid]);

}
__device__ __forceinline__ void check_ffn2(const KArgs& a, const float* hold) {
}

#define N_PHASES 37
#define BISECT_HI N_PHASES

__global__ void __launch_bounds__(NTHREADS, 2) yoco_mega(KArgs a) {
  extern __shared__ __attribute__((aligned(16))) char smem[];
  cg::grid_group grid = cg::this_grid();
  char* ws = a.ws;
  volatile LDS_AS unsigned* xbst = (volatile LDS_AS unsigned*)(smem + SMEM_BYTES - 16);
  if (threadIdx.x == 0) { xbst[0] = 0u; xbst[1] = 0u; }
  __syncthreads();
  const XcdBarrier xb = xcd_barrier_post((unsigned*)(ws + OFF_BAR), xbst);
  const float* rope = (const float*)(ws + OFF_ROPE);
  int ph = 0;
#define GRID_BARRIER() { asm volatile("s_waitcnt vmcnt(0)" ::: "memory"); __builtin_amdgcn_fence(__ATOMIC_RELEASE, "agent"); asm volatile("s_waitcnt vmcnt(0)" ::: "memory"); \
    grid.sync(); __builtin_amdgcn_fence(__ATOMIC_ACQUIRE, "agent"); asm volatile("s_waitcnt vmcnt(0)" ::: "memory"); }
#define PHASE(...) { if (ph >= a.lo && ph < a.hi) { __VA_ARGS__; if (ph + 1 < a.hi) { if (a.lo < 0) { GRID_BARRIER(); } else xcd_barrier(xb); } } ++ph; }
  PHASE(prep_phase(a, smem))
  for (int layer = 0; layer < 4; ++layer) {
    if (layer < 2) {
      const int L = layer;
      const float* hin = (L == 0) ? a.in[I_X] : a.out;
      PHASE(norm_phase(hin, a.in[I_ANORM] + (size_t)L * 1024, (u16*)(ws + OFF_U)))
      PHASE({
        APlain ap{(const u16*)(ws + OFF_U), 1024};
        EpAin ep{(u16*)(ws + OFF_BUFA), (u16*)(ws + OFF_BUFA) + (size_t)T_TOK * 1024};
        gemm_phase(ap, (const u16*)(ws + OFF_W_AIN) + (size_t)L * 2048 * 1024, 1024, 512, 16, ep, smem, 4);
      })
      PHASE(conv_phase(a, L))
      PHASE(gates_phase(a, L, smem))
      PHASE(scan_phase(a, smem))
      PHASE({
        APlain ap{(const u16*)(ws + OFF_U), 1024};
        EpRes ep{hin, a.out, ABL_A};
        gemm_phase(ap, (const u16*)(ws + OFF_W_AOUT) + (size_t)L * 1024 * 1024, 1024, 512, 8, ep, smem, 8);
      })
    } else {
      const int Lb = layer - 2;
      if (Lb == 0) {
        PHASE(norm_phase(a.out, a.in[I_KVNORM], (u16*)(ws + OFF_U)))
        PHASE({
          APlain ap{(const u16*)(ws + OFF_U), 1024};
          EpKV ep{ws, a.in[I_KNORM], rope};
          gemm_phase(ap, (const u16*)(ws + OFF_W_KV), 1024, 512, 12, ep, smem, 4);
        })
        PHASE({
          for (int kv = 0; kv < 2; ++kv) {
            ACmp ap{(const u16*)(ws + (kv == 0 ? OFF_KC : OFF_VC))};
            EpCmp1 ep{(u16*)(ws + OFF_HID) + (size_t)kv * 16256 * 256, (const float*)(ws + OFF_PB) + kv * 16 * 256, a.in[I_CMPB1] + kv * 256};
            gemm_phase(ap, (const u16*)(ws + OFF_W_C1) + (size_t)kv * 256 * 2048, 2048, 127, 2, ep, smem, 2);
          }
        })
        PHASE({
          for (int kv = 0; kv < 2; ++kv) {
            APlain ap{(const u16*)(ws + OFF_HID) + (size_t)kv * 16256 * 256, 256};
            EpCmp2 ep{ws, kv, a.in[I_CMPB2] + kv * 64, a.in[I_KNORM], rope};
            gemm_phase(ap, (const u16*)(ws + OFF_W_C2) + (size_t)kv * 128 * 256, 256, 127, 1, ep, smem, 1);
          }
        })
      }
      PHASE(norm_phase(a.out, a.in[I_BNORM] + (size_t)Lb * 1024, (u16*)(ws + OFF_U)))
      PHASE({
        APlain ap{(const u16*)(ws + OFF_U), 1024};
        EpQ ep{(u16*)(ws + OFF_BUFA), (float*)(ws + OFF_GATES), a.in[I_QNORM] + Lb * 64, a.in[I_BGATEB] + Lb * 48, rope};
        gemm_phase(ap, (const u16*)(ws + OFF_W_BIN) + (size_t)Lb * 1152 * 1024, 1024, 512, 9, ep, smem, 3);
      })
      PHASE(attn_phase(a, smem))
      PHASE({
        APlain ap{(const u16*)(ws + OFF_BUFA) + (size_t)T_TOK * 1024, 1024};
        EpRes ep{a.out, a.out, ABL_B};
        gemm_phase(ap, (const u16*)(ws + OFF_W_BOUT) + (size_t)Lb * 1024 * 1024, 1024, 512, 8, ep, smem, 8);
      })
    }
    PHASE(norm_phase(a.out, a.in[I_FNORM] + (size_t)layer * 1024, (u16*)(ws + OFF_U)))
    PHASE({
      APlain ap{(const u16*)(ws + OFF_U), 1024};
      EpFfn1 ep{(u16*)(ws + OFF_BUFA)};
      gemm_phase(ap, (const u16*)(ws + OFF_W_FIN) + (size_t)layer * 5632 * 1024, 1024, 512, 44, ep, smem, 4);
    })
    PHASE({
      APlain ap{(const u16*)(ws + OFF_BUFA), FHID};
      EpRes ep{a.out, a.out, ABL_F};
      gemm_phase(ap, (const u16*)(ws + OFF_W_FOUT) + (size_t)layer * 1024 * FHID, FHID, 512, 8, ep, smem, 8);
    })
  }
#undef PHASE
}

extern "C" void kernel_launch(void* const* d_in, const int* in_sizes, int n_in, void* d_out, int out_size, void* d_ws, size_t ws_size,
                              hipStream_t stream) {
  static int grid_blocks = 0;
  if (!grid_blocks) {
    int dev = 0, cus = 0, per_cu = 0;
    hipGetDevice(&dev);
    hipDeviceGetAttribute(&cus, hipDeviceAttributeMultiprocessorCount, dev);
    if (hipFuncSetAttribute((const void*)yoco_mega, hipFuncAttributeMaxDynamicSharedMemorySize, SMEM_BYTES) != hipSuccess) fprintf(stderr, "hipFuncSetAttribute failed\n");
    hipOccupancyMaxActiveBlocksPerMultiprocessor(&per_cu, (const void*)yoco_mega, NTHREADS, SMEM_BYTES);
    if (per_cu < 1) per_cu = 1;
    if (per_cu > 2) per_cu = 2;
    grid_blocks = cus * per_cu;
  }
  if (ws_size < WS_END) { fprintf(stderr, "ws too small: %zu < %zu\n", ws_size, (size_t)WS_END); return; }
  { static const int exp_sizes[25] = {65536*1024, 2*1024, 2*1024*2048, 2*4*1024, 2*1024, 2*2*8*128*128, 2*2*1024, 2*1024, 2*1024*1024, 1024, 1024*1536, 3*64, 2*32*64, 2*2048*256, 2*256, 2*256*64, 2*64, 2*1024, 2*1024*1072, 2*48, 2*64, 2*1024*1024, 4*1024, 4*1024*5632, 4*2816*1024};
    if (n_in != 25) return;
    for (int i = 0; i < 25; ++i) if (in_sizes[i] != exp_sizes[i]) { fprintf(stderr, "in_sizes[%d] = %d, expected %d\n", i, in_sizes[i], exp_sizes[i]); return; } }
  KArgs a{};
  for (int i = 0; i < 25; ++i) a.in[i] = (const float*)d_in[i];
  a.out = (float*)d_out;
  a.ws = (char*)d_ws;
  hipMemsetAsync((char*)d_ws + OFF_BAR, 0, XCD_BAR_BYTES, stream);
  hipMemcpyAsync((char*)d_ws + OFF_HID, d_in[5], (size_t)in_sizes[5] * 4, hipMemcpyDeviceToDevice, stream);
#ifdef MULTI_LAUNCH
  for (int ph = 0; ph < N_PHASES; ++ph) {
    a.lo = ph; a.hi = ph + 1;
    hipLaunchKernelGGL(yoco_mega, dim3(grid_blocks), dim3(NTHREADS), SMEM_BYTES, stream, a);
  }
#else
  a.lo = 0; a.hi = BISECT_HI;
  void* args[] = {&a};
  hipError_t e = hipLaunchCooperativeKernel((void*)yoco_mega, dim3(grid_blocks), dim3(NTHREADS), args, SMEM_BYTES, stream);
  if (e != hipSuccess) fprintf(stderr, "cooperative launch failed: %s (grid %d)\n", hipGetErrorString(e), grid_blocks);
#endif
}
```
